# Optimizing an MI355X kernel written in HIP

```python
import math
import jax
import jax.numpy as jnp
from jax import lax
import numpy as np

D_MODEL = 1024
BATCH = 8
SEQ = 8192
DEPTH = 2

GRID_W = 64
CTX_LEN = 256
N_MIXERS = 2
N_HEADS = 8
HEAD_DIM = D_MODEL // N_HEADS
CHUNK = 64
N_GROUPS = 4
EXPERTS_PER_GROUP = 8
N_EXPERTS = N_GROUPS * EXPERTS_PER_GROUP
TOP_K = 2
D_EXPERT = D_MODEL // 2
MOE_BLOCK = 128
N_MOD = 6
EPS = 1e-6

kernel_name = 'hybrid_deltanet_shortconv_hmoe_dit'


def rmsnorm(x, g):
    xf = x.astype(jnp.float32)
    y = xf * lax.rsqrt(jnp.mean(xf * xf, axis=-1, keepdims=True) + EPS)
    return (y * g.astype(jnp.float32)).astype(x.dtype)


def modulate(x, g, shift, scale):
    return rmsnorm(x, g) * (1 + scale) + shift


def ada_params(cond, w, b):
    m = jax.nn.silu(cond) @ w + b
    return jnp.split(m[..., None, :], N_MOD, axis=-1)


def conv3_seq(x, w):
    xp = jnp.pad(x, ((0, 0), (1, 1), (0, 0)))
    return xp[:, :-2] * w[0] + xp[:, 1:-1] * w[1] + xp[:, 2:] * w[2]


def conv3_grid(x, w, rows):
    b, s, ch = x.shape
    half = ch // 2
    g = x.reshape(b, rows, GRID_W, ch)
    wh, wv = w[:, :half], w[:, half:]
    ph = jnp.pad(g[..., :half], ((0, 0), (0, 0), (1, 1), (0, 0)))
    yh = ph[:, :, :-2] * wh[0] + ph[:, :, 1:-1] * wh[1] + ph[:, :, 2:] * wh[2]
    pv = jnp.pad(g[..., half:], ((0, 0), (1, 1), (0, 0), (0, 0)))
    yv = pv[:, :-2] * wv[0] + pv[:, 1:-1] * wv[1] + pv[:, 2:] * wv[2]
    return jnp.concatenate([yh, yv], axis=-1).reshape(b, s, ch)


def l2norm(t):
    return t * lax.rsqrt(jnp.sum(t * t, axis=-1, keepdims=True) + EPS)


def to_chunks(t):
    b, l, h = t.shape[:3]
    t = t.reshape(b, l // CHUNK, CHUNK, h, *t.shape[3:])
    return jnp.moveaxis(t, (1, 3), (0, 2))


def from_chunks(t):
    t = jnp.moveaxis(t, (0, 2), (1, 3))
    b, n, c, h, d = t.shape
    return t.reshape(b, n * c, h, d)


def gated_delta_scan(q, k, v, g, beta, s0, with_output):
    qc, kc, vc = to_chunks(q), to_chunks(k), to_chunks(v)
    gc = jnp.cumsum(to_chunks(g), axis=-1)
    bc = to_chunks(beta)
    pos = jnp.arange(CHUNK)
    incl = pos[:, None] >= pos[None, :]
    decay = jnp.exp(jnp.where(incl, gc[..., :, None] - gc[..., None, :], -jnp.inf))
    kb = kc * bc[..., None]
    lmat = jnp.where(pos[:, None] > pos[None, :],
                     jnp.einsum('nbhid,nbhjd->nbhij', kb, kc) * decay, 0.0)
    rhs = jnp.concatenate([vc * bc[..., None], kb * jnp.exp(gc)[..., None]], axis=-1)
    sol = lax.linalg.triangular_solve(lmat, rhs, left_side=True, lower=True, unit_diagonal=True)
    dv = vc.shape[-1]
    u, w = sol[..., :dv], sol[..., dv:]
    k_dec = kc * jnp.exp(gc[..., -1:] - gc)[..., None]
    g_last = jnp.exp(gc[..., -1])
    xs = (u, w, k_dec, g_last)
    if with_output:
        xs = xs + (qc * jnp.exp(gc)[..., None], jnp.einsum('nbhid,nbhjd->nbhij', qc, kc) * decay)

    def step(s, inp):
        u_i, w_i, kd_i, gl_i = inp[:4]
        v_new = u_i - jnp.einsum('bhcd,bhde->bhce', w_i, s)
        s_next = s * gl_i[..., None, None] + jnp.einsum('bhcd,bhce->bhde', kd_i, v_new)
        if with_output:
            qd_i, qk_i = inp[4:]
            o = jnp.einsum('bhcd,bhde->bhce', qd_i, s) + jnp.einsum('bhij,bhje->bhie', qk_i, v_new)
            return s_next, o
        return s_next, None

    s_final, o = lax.scan(step, s0, xs)
    return s_final, (from_chunks(o) if with_output else None)


def deltanet_mixer(h_lat, h_ctx, w_in, conv_w, a_log, dt_bias, onorm, w_out, ctx_out):
    d, nh, f32 = D_MODEL, N_HEADS, jnp.float32

    def project(h):
        b, l, _ = h.shape
        p = h @ w_in
        qkv = jax.nn.silu(conv3_seq(p[..., :3 * d], conv_w))
        q, k, v = (t.reshape(b, l, nh, HEAD_DIM).astype(f32) for t in jnp.split(qkv, 3, axis=-1))
        q = l2norm(q) * HEAD_DIM ** -0.5
        k = l2norm(k)
        z = p[..., 3 * d:4 * d]
        beta = jax.nn.sigmoid(p[..., 4 * d:4 * d + 2 * nh].astype(f32)).reshape(b, l, 2, nh)
        a_in = p[..., 4 * d + 2 * nh:].astype(f32).reshape(b, l, 2, nh)
        g = -jnp.exp(a_log.astype(f32)) * jax.nn.softplus(a_in + dt_bias.astype(f32))
        return q, k, v, z, beta, g

    def bidir(q, k, v, beta, g, s_f, s_b, with_output):
        flip = lambda t: t[:, ::-1]
        rf = gated_delta_scan(q, k, v, g[:, :, 0], beta[:, :, 0], s_f, with_output)
        rb = gated_delta_scan(flip(q), flip(k), flip(v), flip(g[:, :, 1]), flip(beta[:, :, 1]),
                              s_b, with_output)
        return rf, rb

    def finish(o, z):
        b, l = z.shape[:2]
        o = o * lax.rsqrt(jnp.mean(o * o, axis=-1, keepdims=True) + EPS) * onorm.astype(f32)
        y = o.astype(z.dtype) * jax.nn.silu(z).reshape(b, l, nh, HEAD_DIM)
        return y.reshape(b, l, d) @ w_out

    qc, kc, vc, zc, bc, gc = project(h_ctx)
    s_zero = jnp.zeros((h_ctx.shape[0], nh, HEAD_DIM, HEAD_DIM), f32)
    (sf, ocf), (sb, ocb) = bidir(qc, kc, vc, bc, gc, s_zero, s_zero, ctx_out)
    y_ctx = finish(ocf + ocb[:, ::-1], zc) if ctx_out else None
    ql, kl, vl, zl, bl, gl = project(h_lat)
    (_, olf), (_, olb) = bidir(ql, kl, vl, bl, gl, sf, sb, True)
    y_lat = finish(olf + olb[:, ::-1], zl)
    return y_lat, y_ctx


def shortconv_mixer(h, w_in, conv_w, w_out, rows):
    gate_b, gate_c, hx = jnp.split(h @ w_in, 3, axis=-1)
    u = gate_c * hx
    y = conv3_grid(u, conv_w, rows) if rows is not None else conv3_seq(u, conv_w)
    return (gate_b * y) @ w_out


def hier_moe(h, router_g, router_e, w1, w3, w2):
    f32 = jnp.float32
    t, d = h.shape
    hf = h.astype(f32)
    pg = jax.nn.softmax(hf @ router_g.astype(f32), axis=-1)
    gi = jnp.argmax(pg, axis=-1).astype(jnp.int32)
    pg_sel = jnp.take_along_axis(pg, gi[:, None], axis=-1)
    le = (hf @ router_e.astype(f32)).reshape(t, N_GROUPS, EXPERTS_PER_GROUP)
    le_sel = jnp.take_along_axis(le, gi[:, None, None], axis=1)[:, 0]
    pk, ik = lax.top_k(jax.nn.softmax(le_sel, axis=-1), TOP_K)
    wts = pg_sel * pk / jnp.sum(pk, axis=-1, keepdims=True)
    eid = gi[:, None] * EXPERTS_PER_GROUP + ik.astype(jnp.int32)

    n = t * TOP_K
    n_blocks = -(-n // MOE_BLOCK) + N_EXPERTS
    cap = n_blocks * MOE_BLOCK
    flat_e = eid.reshape(-1)
    flat_tok = jnp.repeat(jnp.arange(t, dtype=jnp.int32), TOP_K)
    flat_w = wts.reshape(-1)
    order = jnp.argsort(flat_e)
    se = flat_e[order]
    counts = jnp.zeros((N_EXPERTS,), jnp.int32).at[flat_e].add(1)
    padded = (counts + MOE_BLOCK - 1) // MOE_BLOCK * MOE_BLOCK
    ends_pad = jnp.cumsum(padded)
    start_pad = ends_pad - padded
    start_raw = jnp.cumsum(counts) - counts
    dest = start_pad[se] + jnp.arange(n, dtype=jnp.int32) - start_raw[se]
    buf_tok = jnp.full((cap,), t, jnp.int32).at[dest].set(flat_tok[order])
    buf_w = jnp.zeros((cap,), f32).at[dest].set(flat_w[order])
    block_e = jnp.minimum(
        jnp.searchsorted(ends_pad, jnp.arange(n_blocks, dtype=jnp.int32) * MOE_BLOCK, side='right'),
        N_EXPERTS - 1).astype(jnp.int32)
    h_pad = jnp.concatenate([h, jnp.zeros((1, d), h.dtype)], axis=0)
    xb = h_pad[buf_tok].reshape(n_blocks, MOE_BLOCK, d)

    def expert_block(args):
        xi, e = args
        return (jax.nn.silu(xi @ w1[e]) * (xi @ w3[e])) @ w2[e]

    yb = lax.map(expert_block, (xb, block_e)).reshape(cap, d)
    y = jax.ops.segment_sum(yb * buf_w[:, None].astype(yb.dtype), buf_tok, num_segments=t + 1)
    return y[:t]


def setup_inputs(seed: int = 0) -> dict:
    key = jax.random.key(seed)
    ks = jax.random.split(key, 24)
    d, nh, f32 = D_MODEL, N_HEADS, jnp.float32
    n_a = (DEPTH + N_MIXERS - 1) // N_MIXERS
    n_b = DEPTH // N_MIXERS

    def nrm(k, shape, scale):
        return jax.random.normal(k, shape, f32) * scale

    dt = jnp.exp(jax.random.uniform(ks[10], (n_a, 2, nh), f32, math.log(1e-3), math.log(1e-1)))
    return {
        'x': nrm(ks[0], (BATCH, SEQ, d), 1.0),
        'c': nrm(ks[1], (BATCH, d), 1.0),
        'ctx': nrm(ks[2], (BATCH, CTX_LEN, d), 1.0),
        'c_ctx': nrm(ks[3], (d,), 1.0),
        'ada_w': nrm(ks[4], (DEPTH, d, N_MOD * d), 0.5 * d ** -0.5),
        'ada_b': nrm(ks[5], (DEPTH, N_MOD * d), 0.02),
        'norm_mix': 1.0 + nrm(ks[6], (DEPTH, d), 0.05),
        'norm_ffn': 1.0 + nrm(ks[7], (DEPTH, d), 0.05),
        'w_in_a': nrm(ks[8], (n_a, d, 4 * d + 4 * nh), d ** -0.5),
        'conv_a': nrm(ks[9], (n_a, 3, 3 * d), 3 ** -0.5),
        'a_log_a': jnp.log(jax.random.uniform(ks[11], (n_a, 2, nh), f32, 1.0, 16.0)),
        'dt_bias_a': dt + jnp.log(-jnp.expm1(-dt)),
        'onorm_a': 1.0 + nrm(ks[12], (n_a, HEAD_DIM), 0.05),
        'w_out_a': nrm(ks[13], (n_a, d, d), d ** -0.5),
        'w_in_b': nrm(ks[14], (n_b, d, 3 * d), d ** -0.5),
        'conv_b': nrm(ks[15], (n_b, 3, d), 3 ** -0.5),
        'w_out_b': nrm(ks[16], (n_b, d, d), d ** -0.5),
        'router_g': nrm(ks[17], (DEPTH, d, N_GROUPS), d ** -0.5),
        'router_e': nrm(ks[18], (DEPTH, d, N_EXPERTS), d ** -0.5),
        'w1': nrm(ks[19], (DEPTH, N_EXPERTS, d, D_EXPERT), d ** -0.5),
        'w3': nrm(ks[20], (DEPTH, N_EXPERTS, d, D_EXPERT), d ** -0.5),
        'w2': nrm(ks[21], (DEPTH, N_EXPERTS, D_EXPERT, d), D_EXPERT ** -0.5),
        'final_norm': 1.0 + nrm(ks[22], (d,), 0.05),
    }


def reference(x, c, ctx, c_ctx, ada_w, ada_b, norm_mix, norm_ffn,
              w_in_a, conv_a, a_log_a, dt_bias_a, onorm_a, w_out_a,
              w_in_b, conv_b, w_out_b, router_g, router_e, w1, w3, w2, final_norm):
    b, s, d = x.shape
    rows = s // GRID_W
    kinds = [i % N_MIXERS for i in range(DEPTH)]
    for i in range(DEPTH):
        kind, j = kinds[i], i // N_MIXERS
        ctx_live = 0 in kinds[i + 1:]
        sh_m, sc_m, gt_m, sh_f, sc_f, gt_f = ada_params(c, ada_w[i], ada_b[i])
        if kind == 0 or ctx_live:
            csh_m, csc_m, cgt_m, csh_f, csc_f, cgt_f = ada_params(c_ctx, ada_w[i], ada_b[i])
            hc = modulate(ctx, norm_mix[i], csh_m, csc_m)
        h = modulate(x, norm_mix[i], sh_m, sc_m)
        if kind == 0:
            y, yc = deltanet_mixer(h, hc, w_in_a[j], conv_a[j], a_log_a[j], dt_bias_a[j],
                                   onorm_a[j], w_out_a[j], ctx_live)
        else:
            y = shortconv_mixer(h, w_in_b[j], conv_b[j], w_out_b[j], rows)
            yc = shortconv_mixer(hc, w_in_b[j], conv_b[j], w_out_b[j], None) if ctx_live else None
        x = x + gt_m * y
        hf = modulate(x, norm_ffn[i], sh_f, sc_f).reshape(b * s, d)
        if ctx_live:
            ctx = ctx + cgt_m * yc
            hcf = modulate(ctx, norm_ffn[i], csh_f, csc_f).reshape(-1, d)
            out = hier_moe(jnp.concatenate([hf, hcf], axis=0), router_g[i], router_e[i],
                           w1[i], w3[i], w2[i])
            x = x + gt_f * out[:b * s].reshape(b, s, d)
            ctx = ctx + cgt_f * out[b * s:].reshape(ctx.shape)
        else:
            x = x + gt_f * hier_moe(hf, router_g[i], router_e[i], w1[i], w3[i], w2[i]).reshape(b, s, d)
    return rmsnorm(x, final_norm)
```

```cpp
#include <hip/hip_runtime.h>
#include <cstdio>
#include <cstdint>

#define LAS __attribute__((address_space(3)))
typedef unsigned short bf16_t;
typedef short bf16x8 __attribute__((ext_vector_type(8)));
typedef short bf16x4 __attribute__((ext_vector_type(4)));
typedef float f32x4 __attribute__((ext_vector_type(4)));
typedef float f32x2 __attribute__((ext_vector_type(2)));
typedef unsigned u32x4 __attribute__((ext_vector_type(4)));
typedef unsigned u32x2 __attribute__((ext_vector_type(2)));
typedef __bf16 bf16v2 __attribute__((ext_vector_type(2)));

#ifndef MK_ONE_LAUNCH
#define MK_ONE_LAUNCH 0
#endif

constexpr int D = 1024, NB = 8, SEQ = 8192, T = NB * SEQ, CTXL = 256, TCTX = NB * CTXL, MROWS = T + TCTX;
constexpr int NH = 8, HD = 128, NE = 32, DE = 512;
constexpr int NPROJ = 4128, NPROJ_PAD = 4352;
constexpr int SLOT_MAX = 2 * T + NE * 256;
constexpr float EPS = 1e-6f;
constexpr int NTHREADS = 512;
constexpr int N_PHASES = 19;

constexpr size_t MiB = 1u << 20;
constexpr size_t WS_CTL = 0;
constexpr size_t CTL_BYTES = 64 * 1024;
constexpr size_t WS_MOD = 1 * MiB;
constexpr size_t WS_META = 2 * MiB;
constexpr size_t WS_WINA = 3 * MiB;
constexpr size_t WS_WOUTA = 12 * MiB;
constexpr size_t WS_WINB = 14 * MiB;
constexpr size_t WS_WOUTB = 20 * MiB;
constexpr size_t WS_W13 = 22 * MiB;
constexpr size_t WS_W2 = 150 * MiB;
constexpr size_t WS_A1 = 214 * MiB;
constexpr size_t WS_BIG = 346 * MiB;
constexpr size_t WS_QKVP = WS_BIG;
constexpr size_t WS_Z = WS_BIG + 396 * MiB;
constexpr size_t WS_GB = WS_BIG + 528 * MiB;
constexpr size_t WS_H = WS_BIG;
constexpr size_t WS_YB = WS_BIG + 136 * MiB;
constexpr size_t WS_REID = WS_BIG + 408 * MiB;
constexpr size_t WS_RWT = WS_REID + 1 * MiB;
constexpr size_t WS_RRANK = WS_REID + 2 * MiB;
constexpr size_t WS_POS = WS_REID + 3 * MiB;
constexpr size_t WS_ROWTOK = WS_REID + 4 * MiB;
constexpr size_t WS_GATEB = WS_BIG;
constexpr size_t WS_U = WS_BIG + 128 * MiB;
constexpr size_t WS_YY = WS_BIG + 256 * MiB;
constexpr size_t WS_END = WS_BIG + 540 * MiB;

__device__ __forceinline__ float bf2f(unsigned short v) { return __uint_as_float(((unsigned)v) << 16); }
__device__ __forceinline__ float bflo(unsigned v) { return __uint_as_float(v << 16); }
__device__ __forceinline__ float bfhi(unsigned v) { return __uint_as_float(v & 0xffff0000u); }
__device__ __forceinline__ unsigned pk_bf16(float a, float b) { f32x2 v = {a, b}; bf16v2 r = __builtin_convertvector(v, bf16v2); return __builtin_bit_cast(unsigned, r); }
__device__ __forceinline__ bf16_t f2bf(float a) { return (bf16_t)(pk_bf16(a, 0.f) & 0xffffu); }
__device__ __forceinline__ float silu_f(float x) { return x * __builtin_amdgcn_rcpf(1.0f + __expf(-x)); }
__device__ __forceinline__ float wave_sum(float v) {
#pragma unroll
    for (int o = 32; o >= 1; o >>= 1) v += __shfl_xor(v, o);
    return v;
}
__device__ __forceinline__ bf16x8 pack8(const f32x4 a, const f32x4 b) {
    u32x4 p; p.x = pk_bf16(a[0], a[1]); p.y = pk_bf16(a[2], a[3]); p.z = pk_bf16(b[0], b[1]); p.w = pk_bf16(b[2], b[3]);
    return __builtin_bit_cast(bf16x8, p);
}
__device__ __forceinline__ bf16x4 pack4(const f32x4 a) { u32x2 p; p.x = pk_bf16(a[0], a[1]); p.y = pk_bf16(a[2], a[3]); return __builtin_bit_cast(bf16x4, p); }
__device__ __forceinline__ bf16x8 cat8(const bf16x4 a, const bf16x4 b) { return __builtin_shufflevector(a, b, 0, 1, 2, 3, 4, 5, 6, 7); }

#define XB_TMO      128
#define XB_XCNT(j)  (256  + 64 * (j))
#define XB_XSUB(j)  (1280 + 64 * (j))
#define XB_XGEN(j)  (2304 + 64 * (j))
#define XB_TOP      3328
#define XB_TOPGEN   3392
#define XCD_BAR_WORDS 3456
#define XB_SPIN_CAP (1u << 18)

__device__ __forceinline__ unsigned xb_ld(unsigned* p)              { return __hip_atomic_load(p, __ATOMIC_RELAXED, __HIP_MEMORY_SCOPE_AGENT); }
__device__ __forceinline__ unsigned xb_add(unsigned* p, unsigned v) { return __hip_atomic_fetch_add(p, v, __ATOMIC_RELAXED, __HIP_MEMORY_SCOPE_AGENT); }
__device__ __forceinline__ unsigned xb_xcc_id() { return (unsigned)__builtin_amdgcn_s_getreg((3 << 11) | 20) & 0xFu; }
#define XB_SPIN(cond, bar) do { unsigned _sp = 0; while (cond) { __builtin_amdgcn_s_sleep(1); \
    if ((++_sp & 255u) == 0u) { if (xb_ld(&(bar)[XB_TMO])) break; if (_sp > XB_SPIN_CAP) { atomicAdd(&(bar)[XB_TMO], 1u); break; } } } } while (0)

struct XcdBarrier { unsigned* bar; unsigned x; volatile LAS unsigned* st; };

__device__ __forceinline__ XcdBarrier xcd_barrier_post(unsigned* bar, volatile LAS unsigned* st) {
    XcdBarrier b; b.bar = bar; b.x = xb_xcc_id(); b.st = st;
    if (threadIdx.x == 0) (void)xb_add(&bar[XB_XCNT(b.x)], 1u);
    return b;
}
__device__ __forceinline__ void xcd_barrier_complete(unsigned* bar, unsigned x, unsigned& nloc, unsigned& nx) {
    const unsigned G = gridDim.x * gridDim.y * gridDim.z;
    unsigned sum, cnt, mine, sp = 0u;
    for (;;) {
        sum = 0u; cnt = 0u; mine = 0u;
#pragma unroll
        for (unsigned j = 0; j < 16; ++j) { const unsigned c = xb_ld(&bar[XB_XCNT(j)]); sum += c; cnt += (c > 0u) ? 1u : 0u; mine = (j == x) ? c : mine; }
        if (sum == G) break;
        __builtin_amdgcn_s_sleep(1);
        if ((++sp & 255u) == 0u) { if (xb_ld(&bar[XB_TMO])) break; if (sp > XB_SPIN_CAP) { atomicAdd(&bar[XB_TMO], 1u); break; } }
    }
    nloc = mine > 0u ? mine : 1u; nx = cnt > 0u ? cnt : 1u;
}
__device__ __forceinline__ void xcd_barrier(const XcdBarrier& b) {
    asm volatile("s_waitcnt vmcnt(0)" ::: "memory");
    __syncthreads();
    if (threadIdx.x == 0) {
        unsigned* bar = b.bar;
        __builtin_amdgcn_s_waitcnt(0);
        unsigned nloc = b.st[0], nx = b.st[1];
        if (nloc == 0u) { xcd_barrier_complete(bar, b.x, nloc, nx); b.st[0] = nloc; b.st[1] = nx; }
        const unsigned old = xb_add(&bar[XB_XSUB(b.x)], 1u);
        const unsigned gen = old / nloc;
        if (old + 1u == (gen + 1u) * nloc) {
            __builtin_amdgcn_fence(__ATOMIC_RELEASE, "agent");
            asm volatile("s_waitcnt vmcnt(0)" ::: "memory");
            const unsigned og = xb_add(&bar[XB_TOP], 1u);
            const unsigned tg = og / nx;
            if (og + 1u == (tg + 1u) * nx) xb_add(&bar[XB_TOPGEN], 1u);
            else XB_SPIN(xb_ld(&bar[XB_TOPGEN]) == tg, bar);
            __builtin_amdgcn_fence(__ATOMIC_ACQUIRE, "agent");
            xb_add(&bar[XB_XGEN(b.x)], 1u);
            asm volatile("s_waitcnt vmcnt(0)" ::: "memory");
        } else {
            XB_SPIN(xb_ld(&bar[XB_XGEN(b.x)]) == gen, bar);
            __builtin_amdgcn_fence(__ATOMIC_ACQUIRE, "agent");
            asm volatile("s_waitcnt vmcnt(0)" ::: "memory");
        }
    }
    __syncthreads();
}

namespace pg8 {
constexpr int BM = 256, BK = 64, HALF = 128, HTB = HALF * BK * 2, STAGE_BYTES = 8 * HTB, NXCD = 8, WGM = 8;
constexpr int TOK_OFF = STAGE_BYTES;
__host__ __device__ __forceinline__ int lds_byte(int r, int c) { const int st = (r >> 4) * 2 + (c >> 5), rr = r & 15, cc = c & 31, ob = rr * 64 + cc * 2; return st * 1024 + (ob ^ (((ob >> 9) & 1) << 5)); }
__host__ __device__ __forceinline__ void stage_rc(int b, int& R, int& C) { const int st = b / 1024, sb = b % 1024, swz = sb ^ (((sb >> 9) & 1) << 5); R = (st >> 1) * 16 + swz / 64; C = (st & 1) * 32 + (swz % 64) / 2; }
__host__ __device__ __forceinline__ int perm32(int rho) { const int n = rho >> 4, i = rho & 15; return 8 * (i >> 2) + 4 * n + (i & 3); }

struct Unit { int pm, pn, brow; };

struct StaticOrder {
    int nM, nN, nwg, G, c;
    __device__ void init(int M, int N, int G_, int c_) { nM = M / BM; nN = N / BM; nwg = nM * nN; G = G_; c = c_; }
    __device__ bool next(int i, Unit& u) const {
        const long L = (long)i * G + c; if (L >= nwg) return false;
        int wgid = (int)L; { const int q = nwg / NXCD, r = nwg % NXCD, xcd = wgid % NXCD, off = wgid / NXCD; wgid = (xcd < r ? xcd * (q + 1) : r * (q + 1) + (xcd - r) * q) + off; }
        const int nig = WGM * nN, gid = wgid / nig, fm = gid * WGM, gsz = (nM - fm) < WGM ? (nM - fm) : WGM;
        u.pm = fm + ((wgid % nig) % gsz); u.pn = (wgid % nig) / gsz; u.brow = u.pn; return true;
    }
};
struct MoeOrder {
    const LAS int* est; int G, c, lw;
    __device__ bool next(int i, Unit& u) const {
        const int U = i * G + c; const int NT = est[NE]; if (U >= NT * 4) return false;
        const int rt = U >> 2; int e = 0;
#pragma unroll
        for (int s = 16; s >= 1; s >>= 1) { if (est[e + s] <= rt) e += s; }
        u.pm = rt; u.pn = U & 3; u.brow = e * lw + (U & 3); return true;
    }
};

template <class Epi, class Sched, bool GATHER>
__device__ __forceinline__ void gemm_phase(LAS unsigned char* lds, const bf16_t* Ag, const bf16_t* Btg, const int K, const Sched& S, const Epi& E, const int* rowtok) {
    const int tid = threadIdx.x, wid = __builtin_amdgcn_readfirstlane(tid >> 6), lane = tid & 63, wr = wid >> 2, wc = wid & 3, fr = lane & 15, fq = lane >> 4;
    const int nt = K / BK;
    unsigned voffB[2], vc[2][2], vn[2][2]; int gR[2], gC[2];
    const size_t kstep = (size_t)(BK * 2);
    const size_t hstep = (size_t)HALF * K * 2;
    const size_t tstep = 2 * hstep;
#pragma unroll
    for (int i = 0; i < 2; ++i) { int R, C; stage_rc(tid * 16 + i * 8192, R, C); const int Rb = Epi::PERM ? ((R & ~31) + perm32(R & 31)) : R;
        gR[i] = R; gC[i] = C; voffB[i] = (unsigned)(Rb * K + C) * 2u;
        vc[0][i] = (unsigned)(R * K + C) * 2u; vc[1][i] = vc[0][i] + (unsigned)hstep; vn[0][i] = vc[0][i]; vn[1][i] = vc[1][i]; }
    const unsigned ldsw = (unsigned)wid * 1024u;
    const int aoff = lds_byte(wr * 64 + fr, fq * 8), boff = lds_byte(wc * 32 + fr, fq * 8);
    LAS int* toks = (LAS int*)(lds + TOK_OFF);
#define PG8_SA(b, h) (((b) * 2 + (h)) * HTB)
#define PG8_SB(b, h) ((4 + (b) * 2 + (h)) * HTB)
#define PG8_STAGE(bufoff, gbase, v0, v1) do { \
        __builtin_amdgcn_global_load_lds((const unsigned*)((const char*)(gbase) + (v0)), (LAS unsigned*)(lds + (bufoff) + ldsw), 16, 0, 0); \
        __builtin_amdgcn_global_load_lds((const unsigned*)((const char*)(gbase) + (v1)), (LAS unsigned*)(lds + (bufoff) + ldsw + 8192), 16, 0, 0); } while (0)
#define PG8_STAGEB(bufoff, gbase) PG8_STAGE(bufoff, gbase, voffB[0], voffB[1])
#define PG8_LDA(dst, b, h) do { _Pragma("unroll") for (int m = 0; m < 4; ++m) _Pragma("unroll") for (int k = 0; k < 2; ++k) dst[m][k] = *(const LAS bf16x8*)(lds + PG8_SA(b, h) + aoff + m * 2048 + k * 1024); } while (0)
#define PG8_LDB(dst, b, h) do { _Pragma("unroll") for (int n = 0; n < 2; ++n) _Pragma("unroll") for (int k = 0; k < 2; ++k) dst[n][k] = *(const LAS bf16x8*)(lds + PG8_SB(b, h) + boff + n * 2048 + k * 1024); } while (0)
#define PG8_MMA(ai, bj, At, Bt) do { __builtin_amdgcn_s_setprio(1); _Pragma("unroll") for (int m = 0; m < 4; ++m) _Pragma("unroll") for (int n = 0; n < 2; ++n) _Pragma("unroll") for (int k = 0; k < 2; ++k) \
        acc[ai][bj][m][n] = __builtin_amdgcn_mfma_f32_16x16x32_bf16(Bt[n][k], At[m][k], acc[ai][bj][m][n], 0, 0, 0); __builtin_amdgcn_s_setprio(0); } while (0)
#define PG8_WAIT_V(n) asm volatile("s_waitcnt vmcnt(" #n ")" ::: "memory")
#define PG8_WAIT_L(n) asm volatile("s_waitcnt lgkmcnt(" #n ")" ::: "memory")
#define PG8_BAR __builtin_amdgcn_s_barrier()
#define PG8_SCHED __builtin_amdgcn_sched_barrier(0)
    Unit cur, nxt; int ui = 0;
    if (!S.next(0, cur)) return;
    f32x4 acc[2][2][4][2];
#pragma unroll
    for (int a = 0; a < 2; ++a)
#pragma unroll
        for (int b = 0; b < 2; ++b)
#pragma unroll
            for (int m = 0; m < 4; ++m)
#pragma unroll
                for (int n = 0; n < 2; ++n) acc[a][b][m][n] = (f32x4){0.f, 0.f, 0.f, 0.f};
    bf16x8 At[4][2], B0[2][2], B1[2][2];
    const char* cA = GATHER ? (const char*)Ag : (const char*)Ag + (size_t)cur.pm * tstep;
    const char* cB = (const char*)Btg + (size_t)cur.brow * tstep;
    if constexpr (GATHER) {
        if (tid < 256) toks[tid] = rowtok[cur.pm * 256 + tid];
        __syncthreads();
#pragma unroll
        for (int h = 0; h < 2; ++h)
#pragma unroll
            for (int i = 0; i < 2; ++i) { vc[h][i] = (unsigned)toks[h * 128 + gR[i]] * (unsigned)(K * 2) + (unsigned)(gC[i] * 2); vn[h][i] = vc[h][i]; }
    }
    PG8_STAGEB(PG8_SB(0, 0), cB); PG8_STAGEB(PG8_SB(0, 1), cB + hstep); PG8_STAGE(PG8_SA(0, 0), cA, vc[0][0], vc[0][1]); PG8_STAGE(PG8_SA(0, 1), cA, vc[1][0], vc[1][1]);
    if (wr == 1) PG8_BAR;
    PG8_WAIT_V(2); PG8_BAR;
    PG8_STAGEB(PG8_SB(1, 0), cB + kstep); PG8_STAGE(PG8_SA(1, 0), cA + kstep, vc[0][0], vc[0][1]); PG8_STAGEB(PG8_SB(1, 1), cB + hstep + kstep);
    PG8_WAIT_V(6); PG8_BAR;
    for (;;) {
        const bool has_next = S.next(ui + 1, nxt);
        const char* nA = GATHER ? (const char*)Ag : (has_next ? (const char*)Ag + (size_t)nxt.pm * tstep : cA);
        const char* nB = has_next ? (const char*)Btg + (size_t)nxt.brow * tstep : cB;
        if constexpr (GATHER) {
            if (has_next && wid < 4) __builtin_amdgcn_global_load_lds((const unsigned*)(rowtok + nxt.pm * 256 + wid * 64 + lane), (LAS unsigned*)(toks + ((ui + 1) & 1) * 256 + wid * 64), 4, 0, 0);
        }
        for (int t = 0; t < nt; t += 2) {
            const bool last = (t == nt - 2);
            const char* a1 = cA + (size_t)(t + 1) * kstep;
            const char* a2 = last ? nA : cA + (size_t)(t + 2) * kstep; const char* b2 = last ? nB : cB + (size_t)(t + 2) * kstep;
            const char* a3 = a2 + kstep; const char* b3 = b2 + kstep;
            if constexpr (GATHER) {
                if (last && has_next) {
                    const LAS int* tk = toks + ((ui + 1) & 1) * 256;
#pragma unroll
                    for (int h = 0; h < 2; ++h)
#pragma unroll
                        for (int i = 0; i < 2; ++i) vn[h][i] = (unsigned)tk[h * 128 + gR[i]] * (unsigned)(K * 2) + (unsigned)(gC[i] * 2);
                }
            }
            const unsigned s00 = last ? vn[0][0] : vc[0][0], s01 = last ? vn[0][1] : vc[0][1], s10 = last ? vn[1][0] : vc[1][0], s11 = last ? vn[1][1] : vc[1][1];
            PG8_LDB(B0, 0, 0); PG8_LDB(B1, 0, 1); PG8_SCHED; PG8_LDA(At, 0, 0); PG8_STAGE(PG8_SA(1, 1), a1, vc[1][0], vc[1][1]);
            PG8_WAIT_V(8); PG8_WAIT_L(0); PG8_BAR; PG8_MMA(0, 0, At, B0); PG8_MMA(0, 1, At, B1); PG8_BAR; PG8_SCHED;
            PG8_LDA(At, 0, 1); PG8_STAGEB(PG8_SB(0, 0), b2); PG8_STAGEB(PG8_SB(0, 1), b2 + hstep); PG8_STAGE(PG8_SA(0, 0), a2, s00, s01);
            PG8_WAIT_V(8); PG8_WAIT_L(0); PG8_BAR; PG8_MMA(1, 0, At, B0); PG8_MMA(1, 1, At, B1); PG8_BAR; PG8_SCHED;
            PG8_LDB(B0, 1, 0); PG8_LDB(B1, 1, 1); PG8_SCHED; PG8_LDA(At, 1, 0); PG8_STAGE(PG8_SA(0, 1), a2, s10, s11);
            PG8_WAIT_V(8); PG8_WAIT_L(0); PG8_BAR; PG8_MMA(0, 0, At, B0); PG8_MMA(0, 1, At, B1); PG8_BAR; PG8_SCHED;
            PG8_LDA(At, 1, 1); PG8_STAGEB(PG8_SB(1, 0), b3); PG8_STAGEB(PG8_SB(1, 1), b3 + hstep); PG8_STAGE(PG8_SA(1, 0), a3, s00, s01);
            PG8_WAIT_V(8); PG8_WAIT_L(0); PG8_BAR; PG8_MMA(1, 0, At, B0); PG8_MMA(1, 1, At, B1); PG8_BAR; PG8_SCHED;
        }
        if (wr == 0) PG8_BAR;
        E(acc, cur, wr, wc, fr, fq);
        if (!has_next) break;
#pragma unroll
        for (int a = 0; a < 2; ++a)
#pragma unroll
            for (int b = 0; b < 2; ++b)
#pragma unroll
                for (int m = 0; m < 4; ++m)
#pragma unroll
                    for (int n = 0; n < 2; ++n) acc[a][b][m][n] = (f32x4){0.f, 0.f, 0.f, 0.f};
        cur = nxt; cA = nA; cB = nB; ++ui;
#pragma unroll
        for (int h = 0; h < 2; ++h)
#pragma unroll
            for (int i = 0; i < 2; ++i) vc[h][i] = vn[h][i];
        if (wr == 1) PG8_BAR;
    }
    PG8_WAIT_V(0);
    PG8_BAR;
#undef PG8_SA
#undef PG8_SB
#undef PG8_STAGE
#undef PG8_STAGEB
#undef PG8_LDA
#undef PG8_LDB
#undef PG8_MMA
#undef PG8_WAIT_V
#undef PG8_WAIT_L
#undef PG8_BAR
#undef PG8_SCHED
}
}

struct EpiInProj {
    static constexpr bool PERM = true;
    bf16_t* qkvp; bf16_t* z; float* gb;
    __device__ __forceinline__ void operator()(const f32x4 (&acc)[2][2][4][2], const pg8::Unit& u, int wr, int wc, int fr, int fq) const {
        const int row0 = u.pm * 256 + wr * 64 + fr;
        if (u.pn < 16) {
            bf16_t* base; int ld, colt;
            if (u.pn < 12) { base = qkvp; ld = 3 * D; colt = u.pn * 256; } else { base = z; ld = D; colt = (u.pn - 12) * 256; }
            const int col0 = colt + wc * 32 + 8 * fq;
#pragma unroll
            for (int ai = 0; ai < 2; ++ai)
#pragma unroll
                for (int m = 0; m < 4; ++m) { bf16_t* rowp = base + (size_t)(row0 + ai * 128 + m * 16) * ld + col0;
#pragma unroll
                    for (int bj = 0; bj < 2; ++bj) { const f32x4 v0 = acc[ai][bj][m][0], v1 = acc[ai][bj][m][1];
                        u32x4 w; w.x = pk_bf16(v0[0], v0[1]); w.y = pk_bf16(v0[2], v0[3]); w.z = pk_bf16(v1[0], v1[1]); w.w = pk_bf16(v1[2], v1[3]);
                        *(u32x4*)(rowp + bj * 128) = w; } }
        } else if (wc == 0) {
            const int lc0 = 8 * fq;
#pragma unroll
            for (int ai = 0; ai < 2; ++ai)
#pragma unroll
                for (int m = 0; m < 4; ++m) { float* rowp = gb + (size_t)(row0 + ai * 128 + m * 16) * 32 + lc0;
                    *(f32x4*)(rowp) = acc[ai][0][m][0]; *(f32x4*)(rowp + 4) = acc[ai][0][m][1]; }
        }
    }
};
struct EpiResid {
    static constexpr bool PERM = false;
    const float* base; float* out; const float* gate;
    __device__ __forceinline__ void operator()(const f32x4 (&acc)[2][2][4][2], const pg8::Unit& u, int wr, int wc, int fr, int fq) const {
        const int row0 = u.pm * 256 + wr * 64 + fr, col0 = u.pn * 256 + wc * 32 + 4 * fq;
        const float* gp = gate + (size_t)((u.pm * 256) / SEQ) * 6144 + col0;
        f32x4 gv[2][2];
#pragma unroll
        for (int bj = 0; bj < 2; ++bj)
#pragma unroll
            for (int n = 0; n < 2; ++n) gv[bj][n] = *(const f32x4*)(gp + bj * 128 + n * 16);
#pragma unroll
        for (int ai = 0; ai < 2; ++ai)
#pragma unroll
            for (int m = 0; m < 4; ++m) { const size_t off = (size_t)(row0 + ai * 128 + m * 16) * D + col0;
#pragma unroll
                for (int bj = 0; bj < 2; ++bj)
#pragma unroll
                    for (int n = 0; n < 2; ++n) { const f32x4 bs = *(const f32x4*)(base + off + bj * 128 + n * 16);
                        *(f32x4*)(out + off + bj * 128 + n * 16) = bs + gv[bj][n] * acc[ai][bj][m][n]; } }
    }
};
struct EpiSwiglu {
    static constexpr bool PERM = true;
    bf16_t* Hb;
    __device__ __forceinline__ void operator()(const f32x4 (&acc)[2][2][4][2], const pg8::Unit& u, int wr, int wc, int fr, int fq) const {
        const int row0 = u.pm * 256 + wr * 64 + fr, col0 = u.pn * 128 + wc * 32 + 8 * fq;
#pragma unroll
        for (int ai = 0; ai < 2; ++ai)
#pragma unroll
            for (int m = 0; m < 4; ++m) { float o[8];
#pragma unroll
                for (int j = 0; j < 8; ++j) { const float a = acc[ai][0][m][j >> 2][j & 3], b = acc[ai][1][m][j >> 2][j & 3]; o[j] = silu_f(a) * b; }
                u32x4 w; w.x = pk_bf16(o[0], o[1]); w.y = pk_bf16(o[2], o[3]); w.z = pk_bf16(o[4], o[5]); w.w = pk_bf16(o[6], o[7]);
                *(u32x4*)(Hb + (size_t)(row0 + ai * 128 + m * 16) * DE + col0) = w; }
    }
};
struct EpiStoreBf16 {
    static constexpr bool PERM = true;
    bf16_t* O; int ld;
    __device__ __forceinline__ void operator()(const f32x4 (&acc)[2][2][4][2], const pg8::Unit& u, int wr, int wc, int fr, int fq) const {
        const int row0 = u.pm * 256 + wr * 64 + fr, col0 = u.pn * 256 + wc * 32 + 8 * fq;
#pragma unroll
        for (int ai = 0; ai < 2; ++ai)
#pragma unroll
            for (int m = 0; m < 4; ++m) { bf16_t* rowp = O + (size_t)(row0 + ai * 128 + m * 16) * ld + col0;
#pragma unroll
                for (int bj = 0; bj < 2; ++bj) { const f32x4 v0 = acc[ai][bj][m][0], v1 = acc[ai][bj][m][1];
                    u32x4 w; w.x = pk_bf16(v0[0], v0[1]); w.y = pk_bf16(v0[2], v0[3]); w.z = pk_bf16(v1[0], v1[1]); w.w = pk_bf16(v1[2], v1[3]);
                    *(u32x4*)(rowp + bj * 128) = w; } }
    }
};
struct EpiInB {
    static constexpr bool PERM = true;
    bf16_t* gateb; bf16_t* ub;
    __device__ __forceinline__ void operator()(const f32x4 (&acc)[2][2][4][2], const pg8::Unit& u, int wr, int wc, int fr, int fq) const {
        const int row0 = u.pm * 256 + wr * 64 + fr;
        if (u.pn < 4) {
            const int col0 = u.pn * 256 + wc * 32 + 8 * fq;
#pragma unroll
            for (int ai = 0; ai < 2; ++ai)
#pragma unroll
                for (int m = 0; m < 4; ++m) { bf16_t* rowp = gateb + (size_t)(row0 + ai * 128 + m * 16) * D + col0;
#pragma unroll
                    for (int bj = 0; bj < 2; ++bj) { const f32x4 v0 = acc[ai][bj][m][0], v1 = acc[ai][bj][m][1];
                        u32x4 w; w.x = pk_bf16(v0[0], v0[1]); w.y = pk_bf16(v0[2], v0[3]); w.z = pk_bf16(v1[0], v1[1]); w.w = pk_bf16(v1[2], v1[3]);
                        *(u32x4*)(rowp + bj * 128) = w; } }
        } else {
            const int col0 = (u.pn - 4) * 128 + wc * 32 + 8 * fq;
#pragma unroll
            for (int ai = 0; ai < 2; ++ai)
#pragma unroll
                for (int m = 0; m < 4; ++m) { const f32x4 a0 = acc[ai][0][m][0], a1 = acc[ai][0][m][1], b0 = acc[ai][1][m][0], b1 = acc[ai][1][m][1];
                    u32x4 w; w.x = pk_bf16(a0[0] * b0[0], a0[1] * b0[1]); w.y = pk_bf16(a0[2] * b0[2], a0[3] * b0[3]); w.z = pk_bf16(a1[0] * b1[0], a1[1] * b1[1]); w.w = pk_bf16(a1[2] * b1[2], a1[3] * b1[3]);
                    *(u32x4*)(ub + (size_t)(row0 + ai * 128 + m * 16) * D + col0) = w; }
        }
    }
};

struct Args { const float* in[23]; float* out; unsigned char* ws; int ph_lo, ph_hi; };

struct Frame {
    LAS unsigned char* lds; int tid, lane, wave, G, bid;
    float* out; unsigned char* ws;
};
#define FIN(k) (args.in[k])

__device__ __forceinline__ void transpose_tile(const Args& args, const Frame& F, const float* src, int lds_, int nvalid, bf16_t* dst, int ldd) {
    LAS float* tile = (LAS float*)F.lds;
    const int r = F.tid >> 4, c4 = (F.tid & 15) * 4;
#pragma unroll
    for (int p = 0; p < 2; ++p) {
        f32x4 v = (f32x4){0.f, 0.f, 0.f, 0.f};
        if (c4 < nvalid) v = *(const f32x4*)(src + (size_t)(r + 32 * p) * lds_ + c4);
#pragma unroll
        for (int j = 0; j < 4; ++j) tile[(r + 32 * p) * 65 + c4 + j] = v[j];
    }
    __syncthreads();
    const int n = F.tid >> 3, kk = (F.tid & 7) * 8;
    float o[8];
#pragma unroll
    for (int j = 0; j < 8; ++j) o[j] = tile[(kk + j) * 65 + n];
    u32x4 w; w.x = pk_bf16(o[0], o[1]); w.y = pk_bf16(o[2], o[3]); w.z = pk_bf16(o[4], o[5]); w.w = pk_bf16(o[6], o[7]);
    *(u32x4*)(dst + (size_t)n * ldd + kk) = w;
    __syncthreads();
}

__device__ __forceinline__ void p0_prologue(const Args& args, const Frame& F) {
    const float* c = args.in[1]; const float* cctx = args.in[3]; const float* ada_w = args.in[4]; const float* ada_b = args.in[5];
    float* MOD = (float*)(F.ws + WS_MOD);
    {
        LAS float* sc = (LAS float*)F.lds;
        LAS float* red = (LAS float*)(F.lds + 9 * 1024 * 4);
        for (int i = F.tid; i < 9 * 1024; i += NTHREADS) { const float v = (i < 8 * 1024) ? c[i] : cctx[i - 8 * 1024]; sc[i] = silu_f(v); }
        __syncthreads();
        const int cc = F.tid & 31, kg = F.tid >> 5;
        for (int q = F.bid; q < 384; q += F.G) {
            const int l = q / 192, n0 = (q % 192) * 32;
            const float* wp = ada_w + (size_t)l * 1024 * 6144 + n0 + cc;
            float a[9];
#pragma unroll
            for (int b = 0; b < 9; ++b) a[b] = 0.f;
            for (int j = 0; j < 64; ++j) { const int k = kg + 16 * j; const float wv = wp[(size_t)k * 6144];
#pragma unroll
                for (int b = 0; b < 9; ++b) a[b] += sc[b * 1024 + k] * wv; }
#pragma unroll
            for (int b = 0; b < 9; ++b) red[(kg * 9 + b) * 32 + cc] = a[b];
            __syncthreads();
            if (F.tid < 288) { const int b = F.tid >> 5; float s = ada_b[l * 6144 + n0 + cc];
#pragma unroll
                for (int g = 0; g < 16; ++g) s += red[(g * 9 + b) * 32 + cc];
                MOD[((size_t)l * 9 + b) * 6144 + n0 + cc] = s; }
            __syncthreads();
        }
    }
    const int NSMALL = 2368, NMOE = 2 * NE * 384;
    for (int q = F.bid; q < NSMALL + NMOE; q += F.G) {
        if (q < 1088) {
            const int ntile = q >> 4, kt = q & 15, n0 = ntile * 64; int nv = NPROJ - n0; nv = nv < 0 ? 0 : (nv > 64 ? 64 : nv);
            transpose_tile(args, F, args.in[8] + (size_t)(kt * 64) * NPROJ + n0, NPROJ, nv, (bf16_t*)(F.ws + WS_WINA) + (size_t)n0 * 1024 + kt * 64, 1024);
        } else if (q < 1344) {
            const int qq = q - 1088, ntile = qq >> 4, kt = qq & 15;
            transpose_tile(args, F, args.in[13] + (size_t)(kt * 64) * D + ntile * 64, D, 64, (bf16_t*)(F.ws + WS_WOUTA) + (size_t)(ntile * 64) * 1024 + kt * 64, 1024);
        } else if (q < 2112) {
            const int qq = q - 1344, ntile = qq >> 4, kt = qq & 15, nd = ntile * 64, j = nd >> 8, w = nd & 255;
            const int ns = (j < 4) ? nd : ((w < 128) ? (1024 + 128 * (j - 4) + w) : (2048 + 128 * (j - 4) + (w - 128)));
            transpose_tile(args, F, args.in[14] + (size_t)(kt * 64) * 3072 + ns, 3072, 64, (bf16_t*)(F.ws + WS_WINB) + (size_t)nd * 1024 + kt * 64, 1024);
        } else if (q < 2368) {
            const int qq = q - 2112, ntile = qq >> 4, kt = qq & 15;
            transpose_tile(args, F, args.in[16] + (size_t)(kt * 64) * D + ntile * 64, D, 64, (bf16_t*)(F.ws + WS_WOUTB) + (size_t)(ntile * 64) * 1024 + kt * 64, 1024);
        } else {
            const int qq = q - NSMALL, le = qq / 384, r = qq % 384;
            if (r < 256) {
                const int ntile = r >> 4, kt = r & 15, nd = ntile * 64, j = nd >> 8, w = nd & 255;
                const float* src = (w < 128) ? args.in[19] : args.in[20]; const int ns = 128 * j + (w & 127);
                transpose_tile(args, F, src + (size_t)le * 1024 * 512 + (size_t)(kt * 64) * 512 + ns, 512, 64, (bf16_t*)(F.ws + WS_W13) + ((size_t)le * 1024 + nd) * 1024 + kt * 64, 1024);
            } else {
                const int rr = r - 256, ntile = rr >> 3, kt = rr & 7;
                transpose_tile(args, F, args.in[21] + (size_t)le * 512 * 1024 + (size_t)(kt * 64) * 1024 + ntile * 64, 1024, 64, (bf16_t*)(F.ws + WS_W2) + ((size_t)le * 1024 + ntile * 64) * 512 + kt * 64, 512);
            }
        }
    }
}

__device__ __forceinline__ void p_modulate0(const Args& args, const Frame& F) {
    const float* x = args.in[0]; const float* ctx = args.in[2]; const float* nrm = args.in[6];
    const float* MOD = (const float*)(F.ws + WS_MOD);
    bf16_t* Hh = (bf16_t*)(F.ws + WS_A1);
    const int nw = F.G * 8, gw = F.bid * 8 + F.wave, per = (MROWS + nw - 1) / nw;
    const int r0 = gw * per, r1 = (r0 + per) < MROWS ? (r0 + per) : MROWS;
    f32x4 gv[4];
#pragma unroll
    for (int j = 0; j < 4; ++j) gv[j] = *(const f32x4*)(nrm + 4 * F.lane + 256 * j);
    for (int r = r0; r < r1; ++r) {
        const float* src; const float* md;
        if (r < T) { src = x + (size_t)r * D; md = MOD + (size_t)(r / SEQ) * 6144; } else { src = ctx + (size_t)(r - T) * D; md = MOD + (size_t)8 * 6144; }
        f32x4 v[4]; float ss = 0.f;
#pragma unroll
        for (int j = 0; j < 4; ++j) { v[j] = *(const f32x4*)(src + 4 * F.lane + 256 * j); ss += v[j][0] * v[j][0] + v[j][1] * v[j][1] + v[j][2] * v[j][2] + v[j][3] * v[j][3]; }
        ss = wave_sum(ss);
        const float rs = rsqrtf(ss * (1.0f / D) + EPS);
#pragma unroll
        for (int j = 0; j < 4; ++j) { const int c = 4 * F.lane + 256 * j; const f32x4 sh = *(const f32x4*)(md + c), scl = *(const f32x4*)(md + 1024 + c);
            const f32x4 o = v[j] * rs * gv[j] * (scl + 1.0f) + sh;
            u32x2 w; w.x = pk_bf16(o[0], o[1]); w.y = pk_bf16(o[2], o[3]); *(u32x2*)(Hh + (size_t)r * D + c) = w; }
    }
}

__device__ __forceinline__ void p_finish(const Args& args, const Frame& F) {
    const bf16_t* OFp = (const bf16_t*)F.out; const bf16_t* OBp = OFp + (size_t)T * D; const bf16_t* Z = (const bf16_t*)(F.ws + WS_Z);
    const float* onorm = args.in[12]; bf16_t* Y = (bf16_t*)(F.ws + WS_A1);
    const int nw = F.G * 8, gw = F.bid * 8 + F.wave, per = (T + nw - 1) / nw;
    const int r0 = gw * per, r1 = (r0 + per) < T ? (r0 + per) : T;
    float on[16];
#pragma unroll
    for (int j = 0; j < 16; ++j) on[j] = onorm[(16 * F.lane + j) & 127];
    for (int r = r0; r < r1; ++r) {
        const size_t off = (size_t)r * D + 16 * F.lane;
        const u32x4 a0 = *(const u32x4*)(OFp + off), a1 = *(const u32x4*)(OFp + off + 8), b0 = *(const u32x4*)(OBp + off), b1 = *(const u32x4*)(OBp + off + 8);
        const u32x4 z0 = *(const u32x4*)(Z + off), z1 = *(const u32x4*)(Z + off + 8);
        float o[16], zz[16]; float ss = 0.f;
#pragma unroll
        for (int j = 0; j < 4; ++j) {
            o[2 * j] = bflo(a0[j]) + bflo(b0[j]); o[2 * j + 1] = bfhi(a0[j]) + bfhi(b0[j]);
            o[8 + 2 * j] = bflo(a1[j]) + bflo(b1[j]); o[8 + 2 * j + 1] = bfhi(a1[j]) + bfhi(b1[j]);
            zz[2 * j] = bflo(z0[j]); zz[2 * j + 1] = bfhi(z0[j]); zz[8 + 2 * j] = bflo(z1[j]); zz[8 + 2 * j + 1] = bfhi(z1[j]); }
#pragma unroll
        for (int j = 0; j < 16; ++j) ss += o[j] * o[j];
        ss += __shfl_xor(ss, 1); ss += __shfl_xor(ss, 2); ss += __shfl_xor(ss, 4);
        const float rs = rsqrtf(ss * (1.0f / HD) + EPS);
        float y[16];
#pragma unroll
        for (int j = 0; j < 16; ++j) y[j] = o[j] * rs * on[j] * silu_f(zz[j]);
        u32x4 w0, w1; w0.x = pk_bf16(y[0], y[1]); w0.y = pk_bf16(y[2], y[3]); w0.z = pk_bf16(y[4], y[5]); w0.w = pk_bf16(y[6], y[7]);
        w1.x = pk_bf16(y[8], y[9]); w1.y = pk_bf16(y[10], y[11]); w1.z = pk_bf16(y[12], y[13]); w1.w = pk_bf16(y[14], y[15]);
        *(u32x4*)(Y + off) = w0; *(u32x4*)(Y + off + 8) = w1;
    }
}

__device__ __forceinline__ void p_ffn_route(const Args& args, const Frame& F, const int l) {
    const float* X = F.out; const float* nrm = args.in[7] + l * D; const float* MOD = (const float*)(F.ws + WS_MOD) + (size_t)l * 9 * 6144;
    const float* rg = args.in[17] + (size_t)l * D * 4; const float* re = args.in[18] + (size_t)l * D * NE;
    bf16_t* Hf = (bf16_t*)(F.ws + WS_A1);
    int* REID = (int*)(F.ws + WS_REID); float* RWT = (float*)(F.ws + WS_RWT); int* RRANK = (int*)(F.ws + WS_RRANK); int* TCNT = (int*)(F.ws + WS_META);
    LAS float* RT = (LAS float*)F.lds;
    LAS int* cntl = (LAS int*)(F.lds + 36 * 1024 * 4);
    for (int i = F.tid; i < 1024 * 4; i += NTHREADS) { const int k = i >> 2, g = i & 3; RT[g * 1024 + k] = rg[i]; }
    for (int i = F.tid; i < 1024 * NE; i += NTHREADS) { const int k = i >> 5, e = i & 31; RT[(4 + e) * 1024 + k] = re[i]; }
    f32x4 gv[4];
#pragma unroll
    for (int j = 0; j < 4; ++j) gv[j] = *(const f32x4*)(nrm + 4 * F.lane + 256 * j);
    for (int tile = F.bid; tile < T / 256; tile += F.G) {
        if (F.tid < 32) cntl[F.tid] = 0;
        __syncthreads();
        for (int rr = 0; rr < 32; ++rr) {
            const int r = tile * 256 + F.wave * 32 + rr;
            const float* src = X + (size_t)r * D; const float* md = MOD + (size_t)(r / SEQ) * 6144;
            f32x4 v[4]; float ss = 0.f;
#pragma unroll
            for (int j = 0; j < 4; ++j) { v[j] = *(const f32x4*)(src + 4 * F.lane + 256 * j); ss += v[j][0] * v[j][0] + v[j][1] * v[j][1] + v[j][2] * v[j][2] + v[j][3] * v[j][3]; }
            ss = wave_sum(ss);
            const float rs = rsqrtf(ss * (1.0f / D) + EPS);
#pragma unroll
            for (int j = 0; j < 4; ++j) { const int c = 4 * F.lane + 256 * j; const f32x4 sh = *(const f32x4*)(md + 3 * 1024 + c), scl = *(const f32x4*)(md + 4 * 1024 + c);
                v[j] = v[j] * rs * gv[j] * (scl + 1.0f) + sh;
                u32x2 w; w.x = pk_bf16(v[j][0], v[j][1]); w.y = pk_bf16(v[j][2], v[j][3]); *(u32x2*)(Hf + (size_t)r * D + c) = w; }
            float lg[4];
#pragma unroll
            for (int g = 0; g < 4; ++g) { float s = 0.f;
#pragma unroll
                for (int j = 0; j < 4; ++j) { const f32x4 w = *(const LAS f32x4*)(RT + g * 1024 + 4 * F.lane + 256 * j); s += v[j][0] * w[0] + v[j][1] * w[1] + v[j][2] * w[2] + v[j][3] * w[3]; }
                lg[g] = wave_sum(s); }
            int gi = 0; float lm = lg[0];
#pragma unroll
            for (int g = 1; g < 4; ++g) if (lg[g] > lm) { lm = lg[g]; gi = g; }
            gi = __builtin_amdgcn_readfirstlane(gi);
            float den = 0.f;
#pragma unroll
            for (int g = 0; g < 4; ++g) den += __expf(lg[g] - lm);
            const float pg = 1.0f / den;
            float le[8];
#pragma unroll
            for (int e = 0; e < 8; ++e) { float s = 0.f; const LAS float* wp = RT + (4 + gi * 8 + e) * 1024 + 4 * F.lane;
#pragma unroll
                for (int j = 0; j < 4; ++j) { const f32x4 w = *(const LAS f32x4*)(wp + 256 * j); s += v[j][0] * w[0] + v[j][1] * w[1] + v[j][2] * w[2] + v[j][3] * w[3]; }
                le[e] = wave_sum(s); }
            int i1 = 0; float m1 = le[0];
#pragma unroll
            for (int e = 1; e < 8; ++e) if (le[e] > m1) { m1 = le[e]; i1 = e; }
            int i2 = -1; float m2 = -3.0e38f;
#pragma unroll
            for (int e = 0; e < 8; ++e) if (e != i1 && le[e] > m2) { m2 = le[e]; i2 = e; }
            const float ex = __expf(m2 - m1); const float w1 = pg / (1.0f + ex), w2 = pg * ex / (1.0f + ex);
            if (F.lane == 0) {
                const int e1 = gi * 8 + i1, e2 = gi * 8 + i2;
                const int k1 = __hip_atomic_fetch_add(cntl + e1, 1, __ATOMIC_RELAXED, __HIP_MEMORY_SCOPE_WORKGROUP); const int k2 = __hip_atomic_fetch_add(cntl + e2, 1, __ATOMIC_RELAXED, __HIP_MEMORY_SCOPE_WORKGROUP);
                REID[2 * r] = e1; REID[2 * r + 1] = e2; RWT[2 * r] = w1; RWT[2 * r + 1] = w2; RRANK[2 * r] = k1; RRANK[2 * r + 1] = k2;
            }
        }
        __syncthreads();
        if (F.tid < 32) TCNT[tile * 32 + F.tid] = cntl[F.tid];
        __syncthreads();
    }
}

__device__ __forceinline__ void p_slots(const Args& args, const Frame& F) {
    const int* TCNT = (const int*)(F.ws + WS_META); int* ESTART = (int*)(F.ws + WS_META) + 256 * 32;
    const int* REID = (const int*)(F.ws + WS_REID); const int* RRANK = (const int*)(F.ws + WS_RRANK); int* POS = (int*)(F.ws + WS_POS); int* ROWTOK = (int*)(F.ws + WS_ROWTOK);
    LAS int* tc = (LAS int*)F.lds;
    LAS int* part = tc + 256 * 32;
    LAS int* tot = part + 16 * 32;
    LAS int* sp = tot + 32;
    for (int i = F.tid; i < 256 * 32; i += NTHREADS) tc[i] = TCNT[i];
    __syncthreads();
    const int e = F.tid & 31, pt = F.tid >> 5;
    { int s = 0; for (int j = 0; j < 16; ++j) { const int v = tc[(pt * 16 + j) * 32 + e]; tc[(pt * 16 + j) * 32 + e] = s; s += v; } part[pt * 32 + e] = s; }
    __syncthreads();
    if (F.tid < 32) { int s = 0; for (int j = 0; j < 16; ++j) { const int v = part[j * 32 + e]; part[j * 32 + e] = s; s += v; } tot[e] = s; }
    __syncthreads();
    if (F.tid == 0) { int s = 0; for (int j = 0; j < 32; ++j) { sp[j] = s; s += (tot[j] + 255) & ~255; } sp[32] = s; }
    __syncthreads();
    if (F.bid == 0 && F.tid < 33) ESTART[F.tid] = sp[F.tid] >> 8;
    for (int tile = F.bid; tile < T / 256; tile += F.G) {
        const int p = tile * 512 + F.tid; const int ee = REID[p];
        const int slot = sp[ee] + part[(tile >> 4) * 32 + ee] + tc[tile * 32 + ee] + RRANK[p];
        POS[p] = slot; ROWTOK[slot] = p >> 1;
    }
    for (int ee = F.bid; ee < NE; ee += F.G) { const int a = sp[ee] + tot[ee], b = sp[ee + 1]; for (int s = a + F.tid; s < b; s += NTHREADS) ROWTOK[s] = 0; }
}

template <bool FINAL>
__device__ __forceinline__ void p_combine(const Args& args, const Frame& F, const int l) {
    float* X = F.out; const bf16_t* YB = (const bf16_t*)(F.ws + WS_YB); const int* POS = (const int*)(F.ws + WS_POS); const float* RWT = (const float*)(F.ws + WS_RWT);
    const float* MODl = (const float*)(F.ws + WS_MOD) + (size_t)l * 9 * 6144;
    const float* MODn = (const float*)(F.ws + WS_MOD) + (size_t)(l + 1) * 9 * 6144;
    const float* nrm = FINAL ? args.in[22] : (args.in[6] + (l + 1) * D);
    bf16_t* Hh = (bf16_t*)(F.ws + WS_A1);
    const int nw = F.G * 8, gw = F.bid * 8 + F.wave, per = (T + nw - 1) / nw;
    const int r0 = gw * per, r1 = (r0 + per) < T ? (r0 + per) : T;
    f32x4 gv[4];
#pragma unroll
    for (int j = 0; j < 4; ++j) gv[j] = *(const f32x4*)(nrm + 4 * F.lane + 256 * j);
    for (int r = r0; r < r1; ++r) {
        const int b = r / SEQ; const int p0 = POS[2 * r], p1 = POS[2 * r + 1]; const float w0 = RWT[2 * r], w1 = RWT[2 * r + 1];
        float* xp = X + (size_t)r * D; const float* gt = MODl + (size_t)b * 6144 + 5 * 1024;
        f32x4 v[4]; float ss = 0.f;
#pragma unroll
        for (int j = 0; j < 4; ++j) { const int c = 4 * F.lane + 256 * j;
            const u32x2 ya = *(const u32x2*)(YB + (size_t)p0 * D + c), yb = *(const u32x2*)(YB + (size_t)p1 * D + c);
            const f32x4 g = *(const f32x4*)(gt + c); f32x4 xv = *(const f32x4*)(xp + c);
            f32x4 m; m[0] = w0 * bflo(ya.x) + w1 * bflo(yb.x); m[1] = w0 * bfhi(ya.x) + w1 * bfhi(yb.x); m[2] = w0 * bflo(ya.y) + w1 * bflo(yb.y); m[3] = w0 * bfhi(ya.y) + w1 * bfhi(yb.y);
            xv = xv + g * m; v[j] = xv;
            ss += xv[0] * xv[0] + xv[1] * xv[1] + xv[2] * xv[2] + xv[3] * xv[3]; }
        ss = wave_sum(ss);
        const float rs = rsqrtf(ss * (1.0f / D) + EPS);
#pragma unroll
        for (int j = 0; j < 4; ++j) { const int c = 4 * F.lane + 256 * j;
            if constexpr (FINAL) { *(f32x4*)(xp + c) = v[j] * rs * gv[j]; }
            else { *(f32x4*)(xp + c) = v[j];
                const float* md = MODn + (size_t)b * 6144; const f32x4 sh = *(const f32x4*)(md + c), scl = *(const f32x4*)(md + 1024 + c);
                const f32x4 o = v[j] * rs * gv[j] * (scl + 1.0f) + sh;
                u32x2 w; w.x = pk_bf16(o[0], o[1]); w.y = pk_bf16(o[2], o[3]); *(u32x2*)(Hh + (size_t)r * D + c) = w; } }
    }
}

__device__ __forceinline__ void p_convgrid(const Args& args, const Frame& F) {
    const bf16_t* GBp = (const bf16_t*)(F.ws + WS_GATEB); const bf16_t* U = (const bf16_t*)(F.ws + WS_U); bf16_t* YY = (bf16_t*)(F.ws + WS_YY);
    const float* cw = args.in[15];
    const int nw = F.G * 8, gw = F.bid * 8 + F.wave, per = (T + nw - 1) / nw;
    const int r0 = gw * per, r1 = (r0 + per) < T ? (r0 + per) : T;
    float w0[16], w1[16], w2[16];
#pragma unroll
    for (int j = 0; j < 16; ++j) { w0[j] = cw[16 * F.lane + j]; w1[j] = cw[1024 + 16 * F.lane + j]; w2[j] = cw[2048 + 16 * F.lane + j]; }
    const bool horiz = F.lane < 32; const int dstep = horiz ? 1 : 64;
    for (int r = r0; r < r1; ++r) {
        const int t = r % SEQ, gc = t & 63, gr = t >> 6;
        const bool hm = horiz ? (gc > 0) : (gr > 0), hp = horiz ? (gc < 63) : (gr < 127);
        const size_t off = (size_t)r * D + 16 * F.lane;
        const u32x4 z = (u32x4){0u, 0u, 0u, 0u};
        const u32x4 c0 = *(const u32x4*)(U + off), c1 = *(const u32x4*)(U + off + 8);
        const u32x4 m0 = hm ? *(const u32x4*)(U + off - (size_t)dstep * D) : z, m1 = hm ? *(const u32x4*)(U + off - (size_t)dstep * D + 8) : z;
        const u32x4 q0 = hp ? *(const u32x4*)(U + off + (size_t)dstep * D) : z, q1 = hp ? *(const u32x4*)(U + off + (size_t)dstep * D + 8) : z;
        const u32x4 g0 = *(const u32x4*)(GBp + off), g1 = *(const u32x4*)(GBp + off + 8);
        float y[16];
#pragma unroll
        for (int j = 0; j < 4; ++j) {
            y[2 * j]         = bflo(g0[j]) * (w0[2 * j] * bflo(m0[j]) + w1[2 * j] * bflo(c0[j]) + w2[2 * j] * bflo(q0[j]));
            y[2 * j + 1]     = bfhi(g0[j]) * (w0[2 * j + 1] * bfhi(m0[j]) + w1[2 * j + 1] * bfhi(c0[j]) + w2[2 * j + 1] * bfhi(q0[j]));
            y[8 + 2 * j]     = bflo(g1[j]) * (w0[8 + 2 * j] * bflo(m1[j]) + w1[8 + 2 * j] * bflo(c1[j]) + w2[8 + 2 * j] * bflo(q1[j]));
            y[8 + 2 * j + 1] = bfhi(g1[j]) * (w0[8 + 2 * j + 1] * bfhi(m1[j]) + w1[8 + 2 * j + 1] * bfhi(c1[j]) + w2[8 + 2 * j + 1] * bfhi(q1[j])); }
        u32x4 o0, o1; o0.x = pk_bf16(y[0], y[1]); o0.y = pk_bf16(y[2], y[3]); o0.z = pk_bf16(y[4], y[5]); o0.w = pk_bf16(y[6], y[7]);
        o1.x = pk_bf16(y[8], y[9]); o1.y = pk_bf16(y[10], y[11]); o1.z = pk_bf16(y[12], y[13]); o1.w = pk_bf16(y[14], y[15]);
        *(u32x4*)(YY + off) = o0; *(u32x4*)(YY + off + 8) = o1;
    }
}

namespace scan {
constexpr int PQ = 136, PT = 72;
constexpr int O_Q = 0, O_K = 17408, O_V = 34816, O_W = 52224, O_O = 69632, O_KT = 87040, O_QK = 105472, O_NL = 114688, O_LD = 123904, O_DM = 129024, O_TAB = 131584, O_CW = 132864, LDS_END = 137472;
__device__ __forceinline__ f32x4 mfma32(const bf16x8 a, const bf16x8 b, const f32x4 c) { return __builtin_amdgcn_mfma_f32_16x16x32_bf16(a, b, c, 0, 0, 0); }
__device__ __forceinline__ f32x4 mfma16(const bf16x4 a, const bf16x4 b, const f32x4 c) { return __builtin_amdgcn_mfma_f32_16x16x16bf16_1k(a, b, c, 0, 0, 0); }
__device__ __forceinline__ bf16x8 ldA_perm(const LAS bf16_t* base, int row, int pitch, int kb, int g4) {
    const bf16x4 lo = *(const LAS bf16x4*)(base + row * pitch + kb + 4 * g4), hi = *(const LAS bf16x4*)(base + row * pitch + kb + 16 + 4 * g4);
    return cat8(lo, hi);
}
}

__device__ __forceinline__ void p_scan(const Args& args, const Frame& F) {
    using namespace scan;
    const bf16_t* QKVP = (const bf16_t*)(F.ws + WS_QKVP); const float* GB = (const float*)(F.ws + WS_GB); const float* conv_a = args.in[9];
    bf16_t* OFp = (bf16_t*)F.out; bf16_t* OBp = OFp + (size_t)T * D;
    LAS bf16_t* Qs = (LAS bf16_t*)(F.lds + O_Q); LAS bf16_t* Ks = (LAS bf16_t*)(F.lds + O_K); LAS bf16_t* Vs = (LAS bf16_t*)(F.lds + O_V); LAS bf16_t* Ws = (LAS bf16_t*)(F.lds + O_W);
    LAS bf16_t* Os = (LAS bf16_t*)(F.lds + O_O); LAS bf16_t* KT = (LAS bf16_t*)(F.lds + O_KT); LAS bf16_t* QKs = (LAS bf16_t*)(F.lds + O_QK); LAS bf16_t* NL = (LAS bf16_t*)(F.lds + O_NL);
    LAS float* LD = (LAS float*)(F.lds + O_LD); LAS bf16_t* DM = (LAS bf16_t*)(F.lds + O_DM);
    LAS float* Tgc = (LAS float*)(F.lds + O_TAB); LAS float* Tbeta = Tgc + 64; LAS float* Teg = Tgc + 128; LAS float* Tekd = Tgc + 192; LAS float* Tegl = Tgc + 256;
    LAS float* CW = (LAS float*)(F.lds + O_CW);
    const int tid = F.tid, wave = F.wave;
    for (int item = F.bid; item < NB * NH * 2; item += F.G) {
        const int dir = item & 1, h = (item >> 1) & 7, b = item >> 4;
        __syncthreads();
        for (int idx = tid; idx < 1152; idx += NTHREADS) { const int mm = idx / 384, tap = (idx >> 7) % 3, ch = idx & 127; CW[idx] = conv_a[tap * 3072 + mm * 1024 + h * 128 + ch]; }
        const float neg_a = -__expf(args.in[10][dir * 8 + h]), dtb = args.in[11][dir * 8 + h];
        __syncthreads();
        f32x4 St[8];
#pragma unroll
        for (int i = 0; i < 8; ++i) St[i] = (f32x4){0.f, 0.f, 0.f, 0.f};
        for (int cc = 0; cc < 132; ++cc) {
            const bool isctx = cc < 4; const int c = isctx ? cc : cc - 4; const int L = isctx ? CTXL : SEQ;
            const int rowbase = isctx ? (T + b * CTXL) : b * SEQ;
            const int t0 = dir ? (L - 1 - 64 * c) : 64 * c; const int ts = dir ? -1 : 1;
            int lane = F.lane;
            asm volatile("" : "+v"(lane));
            if (wave == 0) {
                const int t = t0 + ts * lane; const size_t row = (size_t)(rowbase + t);
                const float araw = GB[row * 32 + 16 + dir * 8 + h], braw = GB[row * 32 + dir * 8 + h];
                const float xx = araw + dtb; const float sp = xx > 15.f ? xx : __logf(1.0f + __expf(xx));
                const float gv = neg_a * sp, bv = __builtin_amdgcn_rcpf(1.0f + __expf(-braw));
                float gc = gv;
#pragma unroll
                for (int o = 1; o < 64; o <<= 1) { const float u = __shfl_up(gc, o); if (lane >= o) gc += u; }
                const float gl = __shfl(gc, 63);
                Tgc[lane] = gc; Tbeta[lane] = bv; Teg[lane] = __expf(gc); Tekd[lane] = __expf(gl - gc); if (lane == 0) Tegl[0] = __expf(gl);
            }
            {
                const int c8 = tid & 15;
#pragma unroll 1
                for (int pp = 0; pp < 2; ++pp) {
                    const int i = (tid >> 4) + 32 * pp;
                    const int t = t0 + ts * i; const bool hm = t > 0, hp = t < L - 1;
                    const bf16_t* rp = QKVP + (size_t)(rowbase + t) * (3 * D) + h * HD + 8 * c8;
#pragma unroll 1
                    for (int mm = 0; mm < 3; ++mm) {
                        const u32x4 z = (u32x4){0u, 0u, 0u, 0u};
                        const u32x4 cu = *(const u32x4*)(rp + mm * D);
                        const u32x4 pv = hm ? *(const u32x4*)(rp + mm * D - 3 * D) : z;
                        const u32x4 nx = hp ? *(const u32x4*)(rp + mm * D + 3 * D) : z;
                        const LAS float* wp = CW + mm * 384 + 8 * c8;
                        const f32x4 wa0 = *(const LAS f32x4*)(wp), wa1 = *(const LAS f32x4*)(wp + 4), wb0 = *(const LAS f32x4*)(wp + 128), wb1 = *(const LAS f32x4*)(wp + 132), wc0 = *(const LAS f32x4*)(wp + 256), wc1 = *(const LAS f32x4*)(wp + 260);
                        float y[8];
#pragma unroll
                        for (int j = 0; j < 4; ++j) {
                            const float w0a = j < 2 ? wa0[2 * j] : wa1[2 * j - 4], w0b = j < 2 ? wa0[2 * j + 1] : wa1[2 * j - 3];
                            const float w1a = j < 2 ? wb0[2 * j] : wb1[2 * j - 4], w1b = j < 2 ? wb0[2 * j + 1] : wb1[2 * j - 3];
                            const float w2a = j < 2 ? wc0[2 * j] : wc1[2 * j - 4], w2b = j < 2 ? wc0[2 * j + 1] : wc1[2 * j - 3];
                            y[2 * j] = silu_f(w0a * bflo(pv[j]) + w1a * bflo(cu[j]) + w2a * bflo(nx[j]));
                            y[2 * j + 1] = silu_f(w0b * bfhi(pv[j]) + w1b * bfhi(cu[j]) + w2b * bfhi(nx[j])); }
                        if (mm < 2) {
                            float ss = 0.f;
#pragma unroll
                            for (int j = 0; j < 8; ++j) ss += y[j] * y[j];
                            ss += __shfl_xor(ss, 1); ss += __shfl_xor(ss, 2); ss += __shfl_xor(ss, 4); ss += __shfl_xor(ss, 8);
                            const float sc = rsqrtf(ss + EPS) * (mm == 0 ? 0.08838834764831845f : 1.0f);
#pragma unroll
                            for (int j = 0; j < 8; ++j) y[j] *= sc;
                        }
                        u32x4 w; w.x = pk_bf16(y[0], y[1]); w.y = pk_bf16(y[2], y[3]); w.z = pk_bf16(y[4], y[5]); w.w = pk_bf16(y[6], y[7]);
                        LAS bf16_t* dst = Qs + mm * (O_K / 2) + i * PQ + 8 * c8;
                        *(LAS u32x4*)dst = w;
                        if (mm == 1) {
                            LAS bf16_t* kt = KT + (8 * c8) * PT + i;
#pragma unroll
                            for (int j = 0; j < 4; ++j) { kt[(2 * j) * PT] = (bf16_t)(w[j] & 0xffffu); kt[(2 * j + 1) * PT] = (bf16_t)(w[j] >> 16); }
                        }
                    }
                }
            }
            __syncthreads();
            asm volatile("" : "+v"(lane));
            {
                const int n16 = lane & 15, g4 = lane >> 4;
                const int p = wave >> 2, rt = wave & 3;
                const LAS bf16_t* Ab = (p ? Qs : Ks) + (16 * rt + n16) * PQ + 8 * g4;
                const LAS bf16_t* Bb = Ks + n16 * PQ + 8 * g4;
                bf16x8 af[4];
#pragma unroll
                for (int s = 0; s < 4; ++s) af[s] = *(const LAS bf16x8*)(Ab + 32 * s);
                const LAS float* tgi = Tgc + 16 * rt + 4 * g4; const LAS float* tbi = Tbeta + 16 * rt + 4 * g4; const LAS float* tgj = Tgc + n16;
                LAS bf16_t* wdst = (p ? QKs : NL) + (16 * rt + 4 * g4) * PT + n16;
                LAS float* ldw = LD + rt * 320 + (4 * g4) * 20 + n16;
                const int il = 4 * g4, jl = n16;
#pragma unroll
                for (int ct = 0; ct < 4; ++ct) {
                    if (ct <= rt) {
                        f32x4 a = (f32x4){0.f, 0.f, 0.f, 0.f};
#pragma unroll
                        for (int s = 0; s < 4; ++s) { const bf16x8 bfr = *(const LAS bf16x8*)(Bb + 16 * ct * PQ + 32 * s); a = mfma32(af[s], bfr, a); }
                        const float gcj = tgj[16 * ct];
                        const bool diag = (ct == rt);
#pragma unroll
                        for (int r = 0; r < 4; ++r) {
                            const float gci = tgi[r];
                            const bool ge = !diag || (il + r >= jl), gt = !diag || (il + r > jl);
                            const float dec = ge ? __expf(gci - gcj) : 0.f; const float val = a[r] * dec;
                            if (p == 0) { const float Lv = gt ? tbi[r] * val : 0.f; wdst[r * PT + 16 * ct] = f2bf(-Lv); if (diag) ldw[r * 20] = Lv; }
                            else wdst[r * PT + 16 * ct] = f2bf(val);
                        }
                    } else if (p == 1) {
#pragma unroll
                        for (int r = 0; r < 4; ++r) wdst[r * PT + 16 * ct] = 0;
                    }
                }
                if (p == 0) {
                    float Dc[16];
                    const LAS float* lr = LD + rt * 320;
#pragma unroll
                    for (int i = 0; i < 16; ++i) {
                        float s = (i == n16) ? 1.f : 0.f;
#pragma unroll
                        for (int j4 = 0; j4 < (i + 3) / 4; ++j4) { const f32x4 lv = *(const LAS f32x4*)(lr + i * 20 + 4 * j4);
#pragma unroll
                            for (int jj = 0; jj < 4; ++jj) if (4 * j4 + jj < i) s -= lv[jj] * Dc[4 * j4 + jj]; }
                        Dc[i] = s;
                    }
                    if (g4 == 0) {
                        LAS bf16_t* dmw = DM + rt * 320 + n16;
#pragma unroll
                        for (int i = 0; i < 16; ++i) dmw[i * 20] = f2bf(Dc[i]);
                    }
                }
            }
            __syncthreads();
            asm volatile("" : "+v"(lane));
            f32x4 Uu[4];
            {
                const int n16 = lane & 15, g4 = lane >> 4;
                const int cl = (4 * g4) * PQ + 16 * wave + n16;
                const LAS bf16_t* vsr = Vs + cl; const LAS bf16_t* ksr = Ks + cl; LAS bf16_t* wsw = Ws + cl;
                const LAS float* tb = Tbeta + 4 * g4; const LAS float* te = Teg + 4 * g4;
                const LAS bf16_t* nlr = NL + n16 * PT + 4 * g4; const LAS bf16_t* dmr = DM + n16 * 20 + 4 * g4;
                f32x4 Xw[4]; bf16x4 xub[4], xwb[4];
#pragma unroll
                for (int bb = 0; bb < 4; ++bb) {
                    f32x4 au, aw;
#pragma unroll
                    for (int r = 0; r < 4; ++r) { const float be = tb[16 * bb + r]; au[r] = be * bf2f(vsr[(16 * bb + r) * PQ]); aw[r] = be * te[16 * bb + r] * bf2f(ksr[(16 * bb + r) * PQ]); }
#pragma unroll
                    for (int kb = 0; kb < 4; ++kb) if (kb < bb) {
                        const bf16x4 la = *(const LAS bf16x4*)(nlr + 16 * bb * PT + 16 * kb);
                        au = mfma16(la, xub[kb], au); aw = mfma16(la, xwb[kb], aw); }
                    const bf16x4 da = *(const LAS bf16x4*)(dmr + bb * 320);
                    const f32x4 zz = (f32x4){0.f, 0.f, 0.f, 0.f};
                    Uu[bb] = mfma16(da, pack4(au), zz); Xw[bb] = mfma16(da, pack4(aw), zz);
                    xub[bb] = pack4(Uu[bb]); xwb[bb] = pack4(Xw[bb]);
#pragma unroll
                    for (int r = 0; r < 4; ++r) wsw[(16 * bb + r) * PQ] = f2bf(Xw[bb][r]);
                }
            }
            __syncthreads();
            asm volatile("" : "+v"(lane));
            {
                const int n16 = lane & 15, g4 = lane >> 4;
                const int lpq = n16 * PQ + 4 * g4, lpt = n16 * PT + 4 * g4;
                const LAS bf16_t* wsr = Ws + lpq; const LAS bf16_t* qsr = Qs + lpq; const LAS bf16_t* qkr = QKs + lpt; const LAS bf16_t* ktr = KT + lpt;
                const LAS float* te = Teg + 4 * g4; const LAS float* tk = Tekd + 4 * g4;
                LAS bf16_t* osw = Os + (4 * g4) * PQ + 16 * wave + n16;
                bf16x8 Sb[4];
#pragma unroll
                for (int s = 0; s < 4; ++s) Sb[s] = pack8(St[2 * s], St[2 * s + 1]);
                f32x4 vn[4];
#pragma unroll
                for (int mt = 0; mt < 4; ++mt) {
                    f32x4 P = (f32x4){0.f, 0.f, 0.f, 0.f};
#pragma unroll
                    for (int s = 0; s < 4; ++s) { const bf16x4 lo = *(const LAS bf16x4*)(wsr + 16 * mt * PQ + 32 * s), hi = *(const LAS bf16x4*)(wsr + 16 * mt * PQ + 32 * s + 16); P = mfma32(cat8(lo, hi), Sb[s], P); }
                    vn[mt] = Uu[mt] - P;
                }
                if (!isctx) {
                    bf16x8 Vb[2]; Vb[0] = pack8(vn[0], vn[1]); Vb[1] = pack8(vn[2], vn[3]);
#pragma unroll
                    for (int mt = 0; mt < 4; ++mt) {
                        f32x4 O = (f32x4){0.f, 0.f, 0.f, 0.f};
#pragma unroll
                        for (int s = 0; s < 4; ++s) { const bf16x4 lo = *(const LAS bf16x4*)(qsr + 16 * mt * PQ + 32 * s), hi = *(const LAS bf16x4*)(qsr + 16 * mt * PQ + 32 * s + 16); O = mfma32(cat8(lo, hi), Sb[s], O); }
#pragma unroll
                        for (int r = 0; r < 4; ++r) O[r] *= te[16 * mt + r];
#pragma unroll
                        for (int s2 = 0; s2 < 2; ++s2) if (2 * s2 <= mt) { const bf16x4 lo = *(const LAS bf16x4*)(qkr + 16 * mt * PT + 32 * s2), hi = *(const LAS bf16x4*)(qkr + 16 * mt * PT + 32 * s2 + 16); O = mfma32(cat8(lo, hi), Vb[s2], O); }
#pragma unroll
                        for (int r = 0; r < 4; ++r) osw[(16 * mt + r) * PQ] = f2bf(O[r]);
                    }
                }
                bf16x8 Vd[2];
                {
                    f32x4 t4[4];
#pragma unroll
                    for (int mt = 0; mt < 4; ++mt)
#pragma unroll
                        for (int r = 0; r < 4; ++r) t4[mt][r] = vn[mt][r] * tk[16 * mt + r];
                    Vd[0] = pack8(t4[0], t4[1]); Vd[1] = pack8(t4[2], t4[3]);
                }
                const float egl = Tegl[0];
#pragma unroll
                for (int dt = 0; dt < 8; ++dt) {
                    f32x4 s = St[dt] * egl;
#pragma unroll
                    for (int s2 = 0; s2 < 2; ++s2) { const bf16x4 lo = *(const LAS bf16x4*)(ktr + 16 * dt * PT + 32 * s2), hi = *(const LAS bf16x4*)(ktr + 16 * dt * PT + 32 * s2 + 16); s = mfma32(cat8(lo, hi), Vd[s2], s); }
                    St[dt] = s;
                }
            }
            __syncthreads();
            if (!isctx) {
                bf16_t* ob = dir ? OBp : OFp;
                const int c8 = tid & 15;
#pragma unroll
                for (int q = 0; q < 2; ++q) { const int i = (tid >> 4) + 32 * q; const int t = t0 + ts * i;
                    const u32x4 v = *(const LAS u32x4*)(Os + i * PQ + 8 * c8);
                    *(u32x4*)(ob + (size_t)(b * SEQ + t) * D + h * HD + 8 * c8) = v; }
            }
        }
    }
}

constexpr int LDS_BYTES = 36 * 1024 * 4 + 1024;
constexpr int LDS_XB = LDS_BYTES - 16;
static_assert(scan::LDS_END <= LDS_XB && pg8::STAGE_BYTES + 2048 <= LDS_XB && 36 * 1024 * 4 + 128 <= LDS_XB, "LDS map");

__device__ __forceinline__ void moe_gemms(const Frame& F, const int l, const bool do1, const bool do2, const XcdBarrier& bar, const bool barrier_between) {
    const int* ESTART = (const int*)(F.ws + WS_META) + 256 * 32;
    LAS int* est = (LAS int*)(F.lds + pg8::TOK_OFF + 2048);
    if (do1) {
        __syncthreads();
        if (F.tid < 33) est[F.tid] = ESTART[F.tid];
        __syncthreads();
        pg8::MoeOrder S{est, F.G, F.bid, 4};
        EpiSwiglu E{(bf16_t*)(F.ws + WS_H)};
        pg8::gemm_phase<EpiSwiglu, pg8::MoeOrder, true>(F.lds, (const bf16_t*)(F.ws + WS_A1), (const bf16_t*)(F.ws + WS_W13) + (size_t)l * NE * 1024 * 1024, D, S, E, (const int*)(F.ws + WS_ROWTOK));
    }
    if (barrier_between) xcd_barrier(bar);
    if (do2) {
        __syncthreads();
        if (F.tid < 33) est[F.tid] = ESTART[F.tid];
        __syncthreads();
        pg8::MoeOrder S{est, F.G, F.bid, 4};
        EpiStoreBf16 E{(bf16_t*)(F.ws + WS_YB), D};
        pg8::gemm_phase<EpiStoreBf16, pg8::MoeOrder, false>(F.lds, (const bf16_t*)(F.ws + WS_H), (const bf16_t*)(F.ws + WS_W2) + (size_t)l * NE * 1024 * 512, DE, S, E, nullptr);
    }
}

__global__ void __launch_bounds__(NTHREADS, 2) hybrid_fwd(Args args) {
    extern __shared__ __attribute__((aligned(16))) unsigned char lds_raw[];
    Frame F;
    F.lds = (LAS unsigned char*)lds_raw; F.tid = threadIdx.x; F.lane = F.tid & 63; F.wave = __builtin_amdgcn_readfirstlane(F.tid >> 6); F.G = gridDim.x; F.bid = blockIdx.x;
    F.out = args.out; F.ws = args.ws;
    const int lo = args.ph_lo, hi = args.ph_hi;
    XcdBarrier bar; bar.bar = (unsigned*)(F.ws + WS_CTL); bar.x = 0; bar.st = (volatile LAS unsigned*)(F.lds + LDS_XB);
    if (hi - lo > 1) {
        if (F.tid == 0) { bar.st[0] = 0u; bar.st[1] = 0u; }
        __syncthreads();
        bar = xcd_barrier_post((unsigned*)(F.ws + WS_CTL), (volatile LAS unsigned*)(F.lds + LDS_XB));
    }
#ifndef PH_MASK
#define PH_MASK 0x7ffff
#endif
#define IN(k) ((((PH_MASK) >> (k)) & 1) && lo <= (k) && (k) < hi)
#define SEAM(k) do { if (IN(k) && IN((k) + 1)) xcd_barrier(bar); } while (0)
    if (IN(0)) p0_prologue(args, F);
    SEAM(0);
    if (IN(1)) p_modulate0(args, F);
    SEAM(1);
    if (IN(2)) {
        pg8::StaticOrder S; S.init(MROWS, NPROJ_PAD, F.G, F.bid);
        EpiInProj E{(bf16_t*)(F.ws + WS_QKVP), (bf16_t*)(F.ws + WS_Z), (float*)(F.ws + WS_GB)};
        pg8::gemm_phase<EpiInProj, pg8::StaticOrder, false>(F.lds, (const bf16_t*)(F.ws + WS_A1), (const bf16_t*)(F.ws + WS_WINA), D, S, E, nullptr);
    }
    SEAM(2);
    if (IN(3)) p_scan(args, F);
    SEAM(3);
    if (IN(4)) p_finish(args, F);
    SEAM(4);
    if (IN(5)) {
        pg8::StaticOrder S; S.init(T, D, F.G, F.bid);
        EpiResid E{args.in[0], F.out, (const float*)(F.ws + WS_MOD) + 2 * 1024};
        pg8::gemm_phase<EpiResid, pg8::StaticOrder, false>(F.lds, (const bf16_t*)(F.ws + WS_A1), (const bf16_t*)(F.ws + WS_WOUTA), D, S, E, nullptr);
    }
    SEAM(5);
    if (IN(6)) p_ffn_route(args, F, 0);
    SEAM(6);
    if (IN(7)) p_slots(args, F);
    SEAM(7);
    if (IN(8) || IN(9)) moe_gemms(F, 0, IN(8), IN(9), bar, IN(8) && IN(9));
    SEAM(9);
    if (IN(10)) p_combine<false>(args, F, 0);
    SEAM(10);
    if (IN(11)) {
        pg8::StaticOrder S; S.init(T, 3 * D, F.G, F.bid);
        EpiInB E{(bf16_t*)(F.ws + WS_GATEB), (bf16_t*)(F.ws + WS_U)};
        pg8::gemm_phase<EpiInB, pg8::StaticOrder, false>(F.lds, (const bf16_t*)(F.ws + WS_A1), (const bf16_t*)(F.ws + WS_WINB), D, S, E, nullptr);
    }
    SEAM(11);
    if (IN(12)) p_convgrid(args, F);
    SEAM(12);
    if (IN(13)) {
        pg8::StaticOrder S; S.init(T, D, F.G, F.bid);
        EpiResid E{F.out, F.out, (const float*)(F.ws + WS_MOD) + (size_t)9 * 6144 + 2 * 1024};
        pg8::gemm_phase<EpiResid, pg8::StaticOrder, false>(F.lds, (const bf16_t*)(F.ws + WS_YY), (const bf16_t*)(F.ws + WS_WOUTB), D, S, E, nullptr);
    }
    SEAM(13);
    if (IN(14)) p_ffn_route(args, F, 1);
    SEAM(14);
    if (IN(15)) p_slots(args, F);
    SEAM(15);
    if (IN(16) || IN(17)) moe_gemms(F, 1, IN(16), IN(17), bar, IN(16) && IN(17));
    SEAM(17);
    if (IN(18)) p_combine<true>(args, F, 1);
#undef IN
#undef SEAM
}

extern "C" void kernel_launch(void* const* d_in, const int* in_sizes, int n_in, void* d_out, int out_size, void* d_ws, size_t ws_size, hipStream_t stream) {
    static int grid = 0;
    if (grid == 0) {
        if (n_in != 23 || out_size != T * D || ws_size < WS_END) { fprintf(stderr, "kernel_launch: unexpected problem shape (n_in %d, out %d, ws %zu < %zu)\n", n_in, out_size, ws_size, (size_t)WS_END); grid = -1; return; }
        int dev = 0, cus = 0, per_cu = 0;
        if (hipGetDevice(&dev) != hipSuccess || hipDeviceGetAttribute(&cus, hipDeviceAttributeMultiprocessorCount, dev) != hipSuccess) { grid = -1; return; }
        if (hipFuncSetAttribute((const void*)hybrid_fwd, hipFuncAttributeMaxDynamicSharedMemorySize, LDS_BYTES) != hipSuccess) { fprintf(stderr, "kernel_launch: hipFuncSetAttribute failed\n"); grid = -1; return; }
        if (hipOccupancyMaxActiveBlocksPerMultiprocessor(&per_cu, (const void*)hybrid_fwd, NTHREADS, LDS_BYTES) != hipSuccess || per_cu < 1) { fprintf(stderr, "kernel_launch: occupancy query says %d\n", per_cu); }
        (void)hipGetLastError();
        grid = cus;
    }
    if (grid < 0) return;
    (void)hipMemsetAsync((char*)d_ws + WS_CTL, 0, CTL_BYTES, stream);
    Args a{};
    for (int i = 0; i < 23; ++i) a.in[i] = (const float*)d_in[i];
    a.out = (float*)d_out; a.ws = (unsigned char*)d_ws;
#if MK_ONE_LAUNCH
    a.ph_lo = 0; a.ph_hi = N_PHASES;
    hipLaunchKernelGGL(hybrid_fwd, dim3(grid), dim3(NTHREADS), LDS_BYTES, stream, a);
#else
    for (int p = 0; p < N_PHASES; ++p) { a.ph_lo = p; a.ph_hi = p + 1; hipLaunchKernelGGL(hybrid_fwd, dim3(grid), dim3(NTHREADS), LDS_BYTES, stream, a); }
#endif
}
```

```cpp
#include <hip/hip_runtime.h>
#include <cstdio>
#include <cstdint>

#define LAS __attribute__((address_space(3)))
typedef unsigned short bf16_t;
typedef short bf16x8 __attribute__((ext_vector_type(8)));
typedef short bf16x4 __attribute__((ext_vector_type(4)));
typedef float f32x4 __attribute__((ext_vector_type(4)));
typedef float f32x2 __attribute__((ext_vector_type(2)));
typedef unsigned u32x4 __attribute__((ext_vector_type(4)));
typedef unsigned u32x2 __attribute__((ext_vector_type(2)));
typedef __bf16 bf16v2 __attribute__((ext_vector_type(2)));
typedef int v8i32 __attribute__((ext_vector_type(8)));
typedef int v4i32 __attribute__((ext_vector_type(4)));

#ifndef MK_ONE_LAUNCH
#define MK_ONE_LAUNCH 1
#endif

constexpr int D = 1024, NB = 8, SEQ = 8192, T = NB * SEQ, CTXL = 256, TCTX = NB * CTXL, MROWS = T + TCTX;
constexpr int NH = 8, HD = 128, NE = 32, DE = 512;
constexpr int NPROJ = 4128, NPROJ_PAD = 4352;
constexpr int SLOT_MAX = 2 * T + NE * 256;
constexpr float EPS = 1e-6f;
constexpr int NTHREADS = 512;
constexpr int N_PHASES = 20;

constexpr size_t MiB = 1u << 20;
constexpr size_t WS_CTL = 0;
constexpr size_t CTL_BYTES = 64 * 1024;
constexpr size_t WS_MOD = 1 * MiB;
constexpr size_t WS_META = 2 * MiB;
constexpr size_t WS_WINA = 3 * MiB;
constexpr size_t WS_WOUTA = 12 * MiB;
constexpr size_t WS_WINB = 14 * MiB;
constexpr size_t WS_WOUTB = 20 * MiB;
constexpr size_t WS_W13 = 22 * MiB;
constexpr size_t WS_W2 = 150 * MiB;
constexpr size_t WS_A1 = 214 * MiB;
constexpr size_t WS_BIG = 346 * MiB;
constexpr size_t WS_QKVP = WS_BIG;
constexpr size_t WS_Z = WS_BIG + 396 * MiB;
constexpr size_t WS_GB = WS_BIG + 528 * MiB;
constexpr size_t WS_H = WS_BIG;
constexpr size_t WS_YB = WS_BIG + 136 * MiB;
constexpr size_t WS_REID = WS_BIG + 408 * MiB;
constexpr size_t WS_RWT = WS_REID + 1 * MiB;
constexpr size_t WS_RRANK = WS_REID + 2 * MiB;
constexpr size_t WS_POS = WS_REID + 3 * MiB;
constexpr size_t WS_ROWTOK = WS_REID + 4 * MiB;
constexpr size_t WS_GATEB = WS_BIG;
constexpr size_t WS_U = WS_BIG + 128 * MiB;
constexpr size_t WS_YY = WS_BIG + 256 * MiB;
constexpr size_t WS_HALO = WS_BIG + 540 * MiB;
constexpr size_t WS_X = WS_BIG + 544 * MiB;
constexpr size_t WS_END = WS_BIG + 672 * MiB;

__device__ __forceinline__ float bf2f(unsigned short v) { return __uint_as_float(((unsigned)v) << 16); }
__device__ __forceinline__ float bflo(unsigned v) { return __uint_as_float(v << 16); }
__device__ __forceinline__ float bfhi(unsigned v) { return __uint_as_float(v & 0xffff0000u); }
__device__ __forceinline__ unsigned pk_bf16(float a, float b) { f32x2 v = {a, b}; bf16v2 r = __builtin_convertvector(v, bf16v2); return __builtin_bit_cast(unsigned, r); }
__device__ __forceinline__ bf16_t f2bf(float a) { return (bf16_t)(pk_bf16(a, 0.f) & 0xffffu); }
__device__ __forceinline__ unsigned pk_fp8x4(float a, float b, float c, float d) {
    a = __builtin_amdgcn_fmed3f(a, -440.f, 440.f); b = __builtin_amdgcn_fmed3f(b, -440.f, 440.f); c = __builtin_amdgcn_fmed3f(c, -440.f, 440.f); d = __builtin_amdgcn_fmed3f(d, -440.f, 440.f);
    int p = 0; p = __builtin_amdgcn_cvt_pk_fp8_f32(a, b, p, false); p = __builtin_amdgcn_cvt_pk_fp8_f32(c, d, p, true); return (unsigned)p; }
constexpr float W13_SCALE = 64.f, W2_SCALE = 32.f, H_SCALE = 4.f, YB_SCALE = 16.f;
__device__ __forceinline__ float silu_f(float x) { return x * __builtin_amdgcn_rcpf(1.0f + __expf(-x)); }
__device__ __forceinline__ float row_sum16(float v) {
    v += __builtin_bit_cast(float, __builtin_amdgcn_update_dpp(0, __builtin_bit_cast(int, v), 0x128, 0xf, 0xf, false));
    v += __builtin_bit_cast(float, __builtin_amdgcn_update_dpp(0, __builtin_bit_cast(int, v), 0x124, 0xf, 0xf, false));
    v += __builtin_bit_cast(float, __builtin_amdgcn_update_dpp(0, __builtin_bit_cast(int, v), 0x122, 0xf, 0xf, false));
    v += __builtin_bit_cast(float, __builtin_amdgcn_update_dpp(0, __builtin_bit_cast(int, v), 0x121, 0xf, 0xf, false));
    return v;
}
__device__ __forceinline__ float wave_sum(float v) { v = row_sum16(v); v += __shfl_xor(v, 16); v += __shfl_xor(v, 32); return v; }
__device__ __forceinline__ bf16x8 pack8(const f32x4 a, const f32x4 b) {
    u32x4 p; p.x = pk_bf16(a[0], a[1]); p.y = pk_bf16(a[2], a[3]); p.z = pk_bf16(b[0], b[1]); p.w = pk_bf16(b[2], b[3]);
    return __builtin_bit_cast(bf16x8, p);
}
__device__ __forceinline__ bf16x4 pack4(const f32x4 a) { u32x2 p; p.x = pk_bf16(a[0], a[1]); p.y = pk_bf16(a[2], a[3]); return __builtin_bit_cast(bf16x4, p); }
__device__ __forceinline__ bf16x8 cat8(const bf16x4 a, const bf16x4 b) { return __builtin_shufflevector(a, b, 0, 1, 2, 3, 4, 5, 6, 7); }

#define XB_TMO      128
#define XB_XCNT(j)  (256  + 64 * (j))
#define XB_XSUB(j)  (1280 + 64 * (j))
#define XB_XGEN(j)  (2304 + 64 * (j))
#define XB_TOP      3328
#define XB_TOPGEN   3392
#define XCD_BAR_WORDS 3456
#define XB_SPIN_CAP (1u << 18)

__device__ __forceinline__ unsigned xb_ld(unsigned* p)              { return __hip_atomic_load(p, __ATOMIC_RELAXED, __HIP_MEMORY_SCOPE_AGENT); }
__device__ __forceinline__ unsigned xb_add(unsigned* p, unsigned v) { return __hip_atomic_fetch_add(p, v, __ATOMIC_RELAXED, __HIP_MEMORY_SCOPE_AGENT); }
__device__ __forceinline__ unsigned xb_xcc_id() { return (unsigned)__builtin_amdgcn_s_getreg((3 << 11) | 20) & 0xFu; }
#define XB_SPIN(cond, bar) do { unsigned _sp = 0; while (cond) { __builtin_amdgcn_s_sleep(1); \
    if ((++_sp & 255u) == 0u) { if (xb_ld(&(bar)[XB_TMO])) break; if (_sp > XB_SPIN_CAP) { atomicAdd(&(bar)[XB_TMO], 1u); break; } } } } while (0)

struct XcdBarrier { unsigned* bar; unsigned x; volatile LAS unsigned* st; };

__device__ __forceinline__ XcdBarrier xcd_barrier_post(unsigned* bar, volatile LAS unsigned* st) {
    XcdBarrier b; b.bar = bar; b.x = xb_xcc_id(); b.st = st;
    if (threadIdx.x == 0) (void)xb_add(&bar[XB_XCNT(b.x)], 1u);
    return b;
}
__device__ __forceinline__ void xcd_barrier_complete(unsigned* bar, unsigned x, unsigned& nloc, unsigned& nx) {
    const unsigned G = gridDim.x * gridDim.y * gridDim.z;
    unsigned sum, cnt, mine, sp = 0u;
    for (;;) {
        sum = 0u; cnt = 0u; mine = 0u;
#pragma unroll
        for (unsigned j = 0; j < 16; ++j) { const unsigned c = xb_ld(&bar[XB_XCNT(j)]); sum += c; cnt += (c > 0u) ? 1u : 0u; mine = (j == x) ? c : mine; }
        if (sum == G) break;
        __builtin_amdgcn_s_sleep(1);
        if ((++sp & 255u) == 0u) { if (xb_ld(&bar[XB_TMO])) break; if (sp > XB_SPIN_CAP) { atomicAdd(&bar[XB_TMO], 1u); break; } }
    }
    nloc = mine > 0u ? mine : 1u; nx = cnt > 0u ? cnt : 1u;
}
__device__ __forceinline__ void xcd_barrier(const XcdBarrier& b) {
    asm volatile("s_waitcnt vmcnt(0)" ::: "memory");
    __syncthreads();
    if (threadIdx.x == 0) {
        unsigned* bar = b.bar;
        __builtin_amdgcn_s_waitcnt(0);
        unsigned nloc = b.st[0], nx = b.st[1];
        if (nloc == 0u) { xcd_barrier_complete(bar, b.x, nloc, nx); b.st[0] = nloc; b.st[1] = nx; }
        const unsigned old = xb_add(&bar[XB_XSUB(b.x)], 1u);
        const unsigned gen = old / nloc;
        if (old + 1u == (gen + 1u) * nloc) {
            __builtin_amdgcn_fence(__ATOMIC_RELEASE, "agent");
            asm volatile("s_waitcnt vmcnt(0)" ::: "memory");
            const unsigned og = xb_add(&bar[XB_TOP], 1u);
            const unsigned tg = og / nx;
            if (og + 1u == (tg + 1u) * nx) xb_add(&bar[XB_TOPGEN], 1u);
            else XB_SPIN(xb_ld(&bar[XB_TOPGEN]) == tg, bar);
            __builtin_amdgcn_fence(__ATOMIC_ACQUIRE, "agent");
            xb_add(&bar[XB_XGEN(b.x)], 1u);
            asm volatile("s_waitcnt vmcnt(0)" ::: "memory");
        } else {
            XB_SPIN(xb_ld(&bar[XB_XGEN(b.x)]) == gen, bar);
            __builtin_amdgcn_fence(__ATOMIC_ACQUIRE, "agent");
            asm volatile("s_waitcnt vmcnt(0)" ::: "memory");
        }
    }
    __syncthreads();
}

namespace pg8 {
constexpr int BM = 256, BK = 64, HALF = 128, HTB = HALF * BK * 2, STAGE_BYTES = 8 * HTB, NXCD = 8, WGM = 8;
constexpr int TOK_OFF = STAGE_BYTES;
__host__ __device__ __forceinline__ int lds_byte(int r, int c) { const int st = (r >> 4) * 2 + (c >> 5), rr = r & 15, cc = c & 31, ob = rr * 64 + cc * 2; return st * 1024 + (ob ^ (((ob >> 9) & 1) << 5)); }
__host__ __device__ __forceinline__ void stage_rc(int b, int& R, int& C) { const int st = b / 1024, sb = b % 1024, swz = sb ^ (((sb >> 9) & 1) << 5); R = (st >> 1) * 16 + swz / 64; C = (st & 1) * 32 + (swz % 64) / 2; }
__host__ __device__ __forceinline__ int perm32(int rho) { const int n = rho >> 4, i = rho & 15; return 8 * (i >> 2) + 4 * n + (i & 3); }

struct Unit { int pm, pn, brow; };

struct StaticOrder {
    int nM, nN, nwg, G, c;
    __device__ void init(int M, int N, int G_, int c_) { nM = M / BM; nN = N / BM; nwg = nM * nN; G = G_; c = c_; }
    __device__ bool next(int i, Unit& u) const {
        const long L = (long)i * G + c; if (L >= nwg) return false;
        int wgid = (int)L; { const int q = nwg / NXCD, r = nwg % NXCD, xcd = wgid % NXCD, off = wgid / NXCD; wgid = (xcd < r ? xcd * (q + 1) : r * (q + 1) + (xcd - r) * q) + off; }
        const int nig = WGM * nN, gid = wgid / nig, fm = gid * WGM, gsz = (nM - fm) < WGM ? (nM - fm) : WGM;
        u.pm = fm + ((wgid % nig) % gsz); u.pn = (wgid % nig) / gsz; u.brow = u.pn; return true;
    }
};
struct MoeOrder {
    const LAS int* est; int G, c, lw;
    __device__ bool next(int i, Unit& u) const {
        const int U = i * G + c; const int NT = est[NE]; if (U >= NT * 4) return false;
        const int rt = U >> 2; int e = 0;
#pragma unroll
        for (int s = 16; s >= 1; s >>= 1) { if (est[e + s] <= rt) e += s; }
        u.pm = rt; u.pn = U & 3; u.brow = e * lw + (U & 3); return true;
    }
};

template <class Epi, class Sched, bool GATHER, int ESZ = 2>
__device__ __forceinline__ void gemm_phase(LAS unsigned char* lds, const bf16_t* Ag, const bf16_t* Btg, const int K, const Sched& S, const Epi& E, const int* rowtok) {
    const int tid = threadIdx.x, wid = __builtin_amdgcn_readfirstlane(tid >> 6), lane = tid & 63, wr = wid >> 2, wc = wid & 3, fr = lane & 15, fq = lane >> 4;
    const int rowb = K * ESZ;
    const int nt = rowb / 128;
    unsigned voffB[2], vc[2][2], vn[2][2]; int gR[2], gC[2];
    const size_t kstep = (size_t)(BK * 2);
    const size_t hstep = (size_t)HALF * rowb;
    const size_t tstep = 2 * hstep;
#pragma unroll
    for (int i = 0; i < 2; ++i) { int R, C; stage_rc(tid * 16 + i * 8192, R, C); const int Rb = Epi::PERM ? ((R & ~31) + perm32(R & 31)) : R;
        gR[i] = R; gC[i] = C; voffB[i] = (unsigned)(Rb * rowb + C * 2);
        vc[0][i] = (unsigned)(R * rowb + C * 2); vc[1][i] = vc[0][i] + (unsigned)hstep; vn[0][i] = vc[0][i]; vn[1][i] = vc[1][i]; }
    const unsigned ldsw = (unsigned)wid * 1024u;
    const int aoff = lds_byte(wr * 64 + fr, fq * 8), boff = lds_byte(wc * 32 + fr, fq * 8);
    LAS int* toks = (LAS int*)(lds + TOK_OFF);
#define PG8_SA(b, h) (((b) * 2 + (h)) * HTB)
#define PG8_SB(b, h) ((4 + (b) * 2 + (h)) * HTB)
#define PG8_STAGE(bufoff, gbase, v0, v1) do { \
        __builtin_amdgcn_global_load_lds((const unsigned*)((const char*)(gbase) + (v0)), (LAS unsigned*)(lds + (bufoff) + ldsw), 16, 0, 0); \
        __builtin_amdgcn_global_load_lds((const unsigned*)((const char*)(gbase) + (v1)), (LAS unsigned*)(lds + (bufoff) + ldsw + 8192), 16, 0, 0); } while (0)
#define PG8_STAGEB(bufoff, gbase) PG8_STAGE(bufoff, gbase, voffB[0], voffB[1])
#define PG8_LDA(dst, b, h) do { _Pragma("unroll") for (int m = 0; m < 4; ++m) _Pragma("unroll") for (int k = 0; k < 2; ++k) dst[m][k] = *(const LAS bf16x8*)(lds + PG8_SA(b, h) + aoff + m * 2048 + k * 1024); } while (0)
#define PG8_LDB(dst, b, h) do { _Pragma("unroll") for (int n = 0; n < 2; ++n) _Pragma("unroll") for (int k = 0; k < 2; ++k) dst[n][k] = *(const LAS bf16x8*)(lds + PG8_SB(b, h) + boff + n * 2048 + k * 1024); } while (0)
#define PG8_MMA(ai, bj, At, Bt) do { __builtin_amdgcn_s_setprio(1); if constexpr (ESZ == 2) { _Pragma("unroll") for (int m = 0; m < 4; ++m) _Pragma("unroll") for (int n = 0; n < 2; ++n) _Pragma("unroll") for (int k = 0; k < 2; ++k) \
        acc[ai][bj][m][n] = __builtin_amdgcn_mfma_f32_16x16x32_bf16(Bt[n][k], At[m][k], acc[ai][bj][m][n], 0, 0, 0); } else { \
        _Pragma("unroll") for (int m = 0; m < 4; ++m) _Pragma("unroll") for (int n = 0; n < 2; ++n) { \
            const v8i32 bb_ = __builtin_shufflevector(__builtin_bit_cast(v4i32, Bt[n][0]), __builtin_bit_cast(v4i32, Bt[n][1]), 0, 1, 2, 3, 4, 5, 6, 7); \
            const v8i32 aa_ = __builtin_shufflevector(__builtin_bit_cast(v4i32, At[m][0]), __builtin_bit_cast(v4i32, At[m][1]), 0, 1, 2, 3, 4, 5, 6, 7); \
            asm volatile("v_mfma_scale_f32_16x16x128_f8f6f4 %0, %1, %2, %0, %3, %3 op_sel_hi:[0,0,0]" : "+v"(acc[ai][bj][m][n]) : "v"(bb_), "v"(aa_), "v"(one_scale)); } } \
        __builtin_amdgcn_s_setprio(0); } while (0)
#define PG8_WAIT_V(n) asm volatile("s_waitcnt vmcnt(" #n ")" ::: "memory")
#define PG8_WAIT_L(n) asm volatile("s_waitcnt lgkmcnt(" #n ")" ::: "memory")
#define PG8_BAR __builtin_amdgcn_s_barrier()
#define PG8_SCHED __builtin_amdgcn_sched_barrier(0)
    const int one_scale = 0x7f7f7f7f;
    Unit cur, nxt; int ui = 0;
    if (!S.next(0, cur)) return;
    f32x4 acc[2][2][4][2];
#pragma unroll
    for (int a = 0; a < 2; ++a)
#pragma unroll
        for (int b = 0; b < 2; ++b)
#pragma unroll
            for (int m = 0; m < 4; ++m)
#pragma unroll
                for (int n = 0; n < 2; ++n) acc[a][b][m][n] = (f32x4){0.f, 0.f, 0.f, 0.f};
    bf16x8 At[4][2], B0[2][2], B1[2][2];
    const char* cA = GATHER ? (const char*)Ag : (const char*)Ag + (size_t)cur.pm * tstep;
    const char* cB = (const char*)Btg + (size_t)cur.brow * tstep;
    if constexpr (GATHER) {
        if (tid < 256) toks[tid] = rowtok[cur.pm * 256 + tid];
        __syncthreads();
#pragma unroll
        for (int h = 0; h < 2; ++h)
#pragma unroll
            for (int i = 0; i < 2; ++i) { vc[h][i] = (unsigned)toks[h * 128 + gR[i]] * (unsigned)rowb + (unsigned)(gC[i] * 2); vn[h][i] = vc[h][i]; }
    }
    PG8_STAGEB(PG8_SB(0, 0), cB); PG8_STAGEB(PG8_SB(0, 1), cB + hstep); PG8_STAGE(PG8_SA(0, 0), cA, vc[0][0], vc[0][1]); PG8_STAGE(PG8_SA(0, 1), cA, vc[1][0], vc[1][1]);
    if (wr == 1) PG8_BAR;
    PG8_WAIT_V(2); PG8_BAR;
    PG8_STAGEB(PG8_SB(1, 0), cB + kstep); PG8_STAGE(PG8_SA(1, 0), cA + kstep, vc[0][0], vc[0][1]); PG8_STAGEB(PG8_SB(1, 1), cB + hstep + kstep);
    PG8_WAIT_V(6); PG8_BAR;
    for (;;) {
        const bool has_next = S.next(ui + 1, nxt);
        const char* nA = GATHER ? (const char*)Ag : (has_next ? (const char*)Ag + (size_t)nxt.pm * tstep : cA);
        const char* nB = has_next ? (const char*)Btg + (size_t)nxt.brow * tstep : cB;
        if constexpr (GATHER) {
            if (has_next && wid < 4) __builtin_amdgcn_global_load_lds((const unsigned*)(rowtok + nxt.pm * 256 + wid * 64 + lane), (LAS unsigned*)(toks + ((ui + 1) & 1) * 256 + wid * 64), 4, 0, 0);
        }
#pragma unroll 1
        for (int t = 0; t < nt; t += 2) {
            const bool last = (t == nt - 2);
            const char* a1 = cA + (size_t)(t + 1) * kstep;
            const char* a2 = last ? nA : cA + (size_t)(t + 2) * kstep; const char* b2 = last ? nB : cB + (size_t)(t + 2) * kstep;
            const char* a3 = a2 + kstep; const char* b3 = b2 + kstep;
            if constexpr (GATHER) {
                if (last && has_next) {
                    const LAS int* tk = toks + ((ui + 1) & 1) * 256;
#pragma unroll
                    for (int h = 0; h < 2; ++h)
#pragma unroll
                        for (int i = 0; i < 2; ++i) vn[h][i] = (unsigned)tk[h * 128 + gR[i]] * (unsigned)rowb + (unsigned)(gC[i] * 2);
                }
            }
            const unsigned s00 = last ? vn[0][0] : vc[0][0], s01 = last ? vn[0][1] : vc[0][1], s10 = last ? vn[1][0] : vc[1][0], s11 = last ? vn[1][1] : vc[1][1];
            PG8_LDB(B0, 0, 0); PG8_LDB(B1, 0, 1); PG8_SCHED; PG8_LDA(At, 0, 0); PG8_STAGE(PG8_SA(1, 1), a1, vc[1][0], vc[1][1]);
            PG8_WAIT_V(8); PG8_WAIT_L(0); PG8_BAR; PG8_MMA(0, 0, At, B0); PG8_MMA(0, 1, At, B1); PG8_BAR; PG8_SCHED;
            PG8_LDA(At, 0, 1); PG8_STAGEB(PG8_SB(0, 0), b2); PG8_STAGEB(PG8_SB(0, 1), b2 + hstep); PG8_STAGE(PG8_SA(0, 0), a2, s00, s01);
            PG8_WAIT_V(8); PG8_WAIT_L(0); PG8_BAR; PG8_MMA(1, 0, At, B0); PG8_MMA(1, 1, At, B1); PG8_BAR; PG8_SCHED;
            PG8_LDB(B0, 1, 0); PG8_LDB(B1, 1, 1); PG8_SCHED; PG8_LDA(At, 1, 0); PG8_STAGE(PG8_SA(0, 1), a2, s10, s11);
            PG8_WAIT_V(8); PG8_WAIT_L(0); PG8_BAR; PG8_MMA(0, 0, At, B0); PG8_MMA(0, 1, At, B1); PG8_BAR; PG8_SCHED;
            PG8_LDA(At, 1, 1); PG8_STAGEB(PG8_SB(1, 0), b3); PG8_STAGEB(PG8_SB(1, 1), b3 + hstep); PG8_STAGE(PG8_SA(1, 0), a3, s00, s01);
            PG8_WAIT_V(8); PG8_WAIT_L(0); PG8_BAR; PG8_MMA(1, 0, At, B0); PG8_MMA(1, 1, At, B1); PG8_BAR; PG8_SCHED;
        }
        if (wr == 0) PG8_BAR;
        if constexpr (ESZ == 1) asm volatile("s_nop 15\n\ts_nop 15\n\ts_nop 15" ::: "memory");
        E(acc, cur, wr, wc, fr, fq);
        if (!has_next) break;
#pragma unroll
        for (int a = 0; a < 2; ++a)
#pragma unroll
            for (int b = 0; b < 2; ++b)
#pragma unroll
                for (int m = 0; m < 4; ++m)
#pragma unroll
                    for (int n = 0; n < 2; ++n) acc[a][b][m][n] = (f32x4){0.f, 0.f, 0.f, 0.f};
        cur = nxt; cA = nA; cB = nB; ++ui;
#pragma unroll
        for (int h = 0; h < 2; ++h)
#pragma unroll
            for (int i = 0; i < 2; ++i) vc[h][i] = vn[h][i];
        if (wr == 1) PG8_BAR;
    }
    PG8_WAIT_V(0);
    PG8_BAR;
#undef PG8_SA
#undef PG8_SB
#undef PG8_STAGE
#undef PG8_STAGEB
#undef PG8_LDA
#undef PG8_LDB
#undef PG8_MMA
#undef PG8_WAIT_V
#undef PG8_WAIT_L
#undef PG8_BAR
#undef PG8_SCHED
}
}

struct EpiInProj {
    static constexpr bool PERM = true;
    bf16_t* qkvp; bf16_t* z; float* gb; bf16_t* halo;
    __device__ __forceinline__ void operator()(const f32x4 (&acc)[2][2][4][2], const pg8::Unit& u, int wr, int wc, int fr, int fq) const {
        const int row0 = u.pm * 256 + wr * 64 + fr;
        if (u.pn < 16) {
            bf16_t* base; int ld, colt;
            if (u.pn < 12) { base = qkvp; ld = 3 * D; colt = u.pn * 256; } else { base = z; ld = D; colt = (u.pn - 12) * 256; }
            const int col0 = colt + wc * 32 + 8 * fq;
#pragma unroll
            for (int ai = 0; ai < 2; ++ai)
#pragma unroll
                for (int m = 0; m < 4; ++m) { bf16_t* rowp = base + (size_t)(row0 + ai * 128 + m * 16) * ld + col0;
#pragma unroll
                    for (int bj = 0; bj < 2; ++bj) { const f32x4 v0 = acc[ai][bj][m][0], v1 = acc[ai][bj][m][1];
                        u32x4 w; w.x = pk_bf16(v0[0], v0[1]); w.y = pk_bf16(v0[2], v0[3]); w.z = pk_bf16(v1[0], v1[1]); w.w = pk_bf16(v1[2], v1[3]);
                        __builtin_nontemporal_store(w, (u32x4*)(rowp + bj * 128));
                        if (u.pn < 12 && fr == (ai ? 15 : 0) && wr == ai && m == (ai ? 3 : 0)) *(u32x4*)(halo + ((size_t)u.pm * 2 + ai) * (3 * D) + col0 + bj * 128) = w; } }
        } else if (wc == 0) {
            const int lc0 = 8 * fq;
#pragma unroll
            for (int ai = 0; ai < 2; ++ai)
#pragma unroll
                for (int m = 0; m < 4; ++m) { float* rowp = gb + (size_t)(row0 + ai * 128 + m * 16) * 32 + lc0;
                    *(f32x4*)(rowp) = acc[ai][0][m][0]; *(f32x4*)(rowp + 4) = acc[ai][0][m][1]; }
        }
    }
};
template <bool BASE_BF16> struct EpiResid {
    static constexpr bool PERM = true;
    const void* base; bf16_t* out; const float* gate;
    __device__ __forceinline__ void operator()(const f32x4 (&acc)[2][2][4][2], const pg8::Unit& u, int wr, int wc, int fr, int fq) const {
        const int row0 = u.pm * 256 + wr * 64 + fr, col0 = u.pn * 256 + wc * 32 + 8 * fq;
        const float* gp = gate + (size_t)((u.pm * 256) / SEQ) * 6144 + col0;
        f32x4 gv[2][2];
#pragma unroll
        for (int bj = 0; bj < 2; ++bj)
#pragma unroll
            for (int n = 0; n < 2; ++n) gv[bj][n] = *(const f32x4*)(gp + bj * 128 + n * 4);
#pragma unroll
        for (int ai = 0; ai < 2; ++ai)
#pragma unroll
            for (int mp = 0; mp < 2; ++mp) {
                f32x4 b[2][2][2];
#pragma unroll
                for (int mm = 0; mm < 2; ++mm) { const size_t off = (size_t)(row0 + ai * 128 + (2 * mp + mm) * 16) * D + col0;
#pragma unroll
                    for (int bj = 0; bj < 2; ++bj) {
                        if constexpr (BASE_BF16) { const u32x4 t = *(const u32x4*)((const bf16_t*)base + off + bj * 128); b[mm][bj][0] = (f32x4){bflo(t.x), bfhi(t.x), bflo(t.y), bfhi(t.y)}; b[mm][bj][1] = (f32x4){bflo(t.z), bfhi(t.z), bflo(t.w), bfhi(t.w)}; }
                        else { b[mm][bj][0] = *(const f32x4*)((const float*)base + off + bj * 128); b[mm][bj][1] = *(const f32x4*)((const float*)base + off + bj * 128 + 4); } } }
                __builtin_amdgcn_sched_barrier(0);
#pragma unroll
                for (int mm = 0; mm < 2; ++mm) { const int m = 2 * mp + mm; const size_t off = (size_t)(row0 + ai * 128 + m * 16) * D + col0;
#pragma unroll
                    for (int bj = 0; bj < 2; ++bj) {
                        const f32x4 v0 = b[mm][bj][0] + gv[bj][0] * acc[ai][bj][m][0], v1 = b[mm][bj][1] + gv[bj][1] * acc[ai][bj][m][1];
                        u32x4 w; w.x = pk_bf16(v0[0], v0[1]); w.y = pk_bf16(v0[2], v0[3]); w.z = pk_bf16(v1[0], v1[1]); w.w = pk_bf16(v1[2], v1[3]);
                        *(u32x4*)(out + off + bj * 128) = w; } }
                __builtin_amdgcn_sched_barrier(0);
            }
    }
};
struct EpiSwiglu {
    static constexpr bool PERM = true;
    unsigned char* Hb;
    __device__ __forceinline__ void operator()(const f32x4 (&acc)[2][2][4][2], const pg8::Unit& u, int wr, int wc, int fr, int fq) const {
        const int row0 = u.pm * 256 + wr * 64 + fr, col0 = u.pn * 128 + wc * 32 + 8 * fq;
        const float is = 1.0f / W13_SCALE;
#pragma unroll
        for (int ai = 0; ai < 2; ++ai)
#pragma unroll
            for (int m = 0; m < 4; ++m) { float o[8];
#pragma unroll
                for (int j = 0; j < 8; ++j) { const float a = acc[ai][0][m][j >> 2][j & 3], b = acc[ai][1][m][j >> 2][j & 3];
                    const float r = __builtin_amdgcn_rcpf(1.0f + __builtin_amdgcn_exp2f(a * (-is * 1.4426950408889634f))); o[j] = (a * b) * (r * (is * is * H_SCALE)); }
                u32x2 w; w.x = pk_fp8x4(o[0], o[1], o[2], o[3]); w.y = pk_fp8x4(o[4], o[5], o[6], o[7]);
                *(u32x2*)(Hb + (size_t)(row0 + ai * 128 + m * 16) * DE + col0) = w; }
    }
};
struct EpiStoreFp8 {
    static constexpr bool PERM = true;
    unsigned char* O; int ld; float sc;
    __device__ __forceinline__ void operator()(const f32x4 (&acc)[2][2][4][2], const pg8::Unit& u, int wr, int wc, int fr, int fq) const {
        const int row0 = u.pm * 256 + wr * 64 + fr, col0 = u.pn * 256 + wc * 32 + 8 * fq;
#pragma unroll
        for (int ai = 0; ai < 2; ++ai)
#pragma unroll
            for (int m = 0; m < 4; ++m) { unsigned char* rowp = O + (size_t)(row0 + ai * 128 + m * 16) * ld + col0;
#pragma unroll
                for (int bj = 0; bj < 2; ++bj) { const f32x4 v0 = acc[ai][bj][m][0] * sc, v1 = acc[ai][bj][m][1] * sc;
                    u32x2 w; w.x = pk_fp8x4(v0[0], v0[1], v0[2], v0[3]); w.y = pk_fp8x4(v1[0], v1[1], v1[2], v1[3]);
                    *(u32x2*)(rowp + bj * 128) = w; } }
    }
};
struct EpiInB {
    static constexpr bool PERM = true;
    bf16_t* gateb; bf16_t* ub;
    __device__ __forceinline__ void operator()(const f32x4 (&acc)[2][2][4][2], const pg8::Unit& u, int wr, int wc, int fr, int fq) const {
        const int row0 = u.pm * 256 + wr * 64 + fr;
        if (u.pn < 4) {
            const int col0 = u.pn * 256 + wc * 32 + 8 * fq;
#pragma unroll
            for (int ai = 0; ai < 2; ++ai)
#pragma unroll
                for (int m = 0; m < 4; ++m) { bf16_t* rowp = gateb + (size_t)(row0 + ai * 128 + m * 16) * D + col0;
#pragma unroll
                    for (int bj = 0; bj < 2; ++bj) { const f32x4 v0 = acc[ai][bj][m][0], v1 = acc[ai][bj][m][1];
                        u32x4 w; w.x = pk_bf16(v0[0], v0[1]); w.y = pk_bf16(v0[2], v0[3]); w.z = pk_bf16(v1[0], v1[1]); w.w = pk_bf16(v1[2], v1[3]);
                        *(u32x4*)(rowp + bj * 128) = w; } }
        } else {
            const int col0 = (u.pn - 4) * 128 + wc * 32 + 8 * fq;
#pragma unroll
            for (int ai = 0; ai < 2; ++ai)
#pragma unroll
                for (int m = 0; m < 4; ++m) { const f32x4 a0 = acc[ai][0][m][0], a1 = acc[ai][0][m][1], b0 = acc[ai][1][m][0], b1 = acc[ai][1][m][1];
                    u32x4 w; w.x = pk_bf16(a0[0] * b0[0], a0[1] * b0[1]); w.y = pk_bf16(a0[2] * b0[2], a0[3] * b0[3]); w.z = pk_bf16(a1[0] * b1[0], a1[1] * b1[1]); w.w = pk_bf16(a1[2] * b1[2], a1[3] * b1[3]);
                    *(u32x4*)(ub + (size_t)(row0 + ai * 128 + m * 16) * D + col0) = w; }
        }
    }
};

struct Args { const float* in[23]; float* out; unsigned char* ws; int ph_lo, ph_hi, li, pad; };

struct Frame {
    LAS unsigned char* lds; int tid, lane, wave, G, bid;
    float* out; unsigned char* ws;
};
#define FIN(k) (args.in[k])

__device__ __forceinline__ void transpose_tile(const Args& args, const Frame& F, const float* src, int lds_, int nvalid, bf16_t* dst, int ldd) {
    LAS float* tile = (LAS float*)F.lds;
    const int r = F.tid >> 4, c4 = (F.tid & 15) * 4;
#pragma unroll
    for (int p = 0; p < 2; ++p) {
        f32x4 v = (f32x4){0.f, 0.f, 0.f, 0.f};
        if (c4 < nvalid) v = *(const f32x4*)(src + (size_t)(r + 32 * p) * lds_ + c4);
#pragma unroll
        for (int j = 0; j < 4; ++j) tile[(r + 32 * p) * 65 + c4 + j] = v[j];
    }
    __syncthreads();
    const int n = F.tid >> 3, kk = (F.tid & 7) * 8;
    float o[8];
#pragma unroll
    for (int j = 0; j < 8; ++j) o[j] = tile[(kk + j) * 65 + n];
    u32x4 w; w.x = pk_bf16(o[0], o[1]); w.y = pk_bf16(o[2], o[3]); w.z = pk_bf16(o[4], o[5]); w.w = pk_bf16(o[6], o[7]);
    *(u32x4*)(dst + (size_t)n * ldd + kk) = w;
    __syncthreads();
}

__device__ __forceinline__ void transpose_tile_fp8(const Args& args, const Frame& F, const float* src, int lds_, unsigned char* dst, int ldd, float sc) {
    LAS float* tile = (LAS float*)F.lds;
    const int r = F.tid >> 4, c4 = (F.tid & 15) * 4;
#pragma unroll
    for (int p = 0; p < 2; ++p) {
        const f32x4 v = *(const f32x4*)(src + (size_t)(r + 32 * p) * lds_ + c4);
#pragma unroll
        for (int j = 0; j < 4; ++j) tile[(r + 32 * p) * 65 + c4 + j] = v[j] * sc;
    }
    __syncthreads();
    const int n = F.tid >> 3, kk = (F.tid & 7) * 8;
    float o[8];
#pragma unroll
    for (int j = 0; j < 8; ++j) o[j] = tile[(kk + j) * 65 + n];
    u32x2 w; w.x = pk_fp8x4(o[0], o[1], o[2], o[3]); w.y = pk_fp8x4(o[4], o[5], o[6], o[7]);
    *(u32x2*)(dst + (size_t)n * ldd + kk) = w;
    __syncthreads();
}
__device__ __forceinline__ void p0_prologue(const Args& args, const Frame& F) {
    const float* c = args.in[1]; const float* cctx = args.in[3]; const float* ada_w = args.in[4]; const float* ada_b = args.in[5];
    float* MOD = (float*)(F.ws + WS_MOD);
    {
        LAS float* sc = (LAS float*)F.lds;
        LAS float* red = (LAS float*)(F.lds + 9 * 1024 * 4);
        for (int i = F.tid; i < 9 * 1024; i += NTHREADS) { const float v = (i < 8 * 1024) ? c[i] : cctx[i - 8 * 1024]; sc[i] = silu_f(v); }
        __syncthreads();
        const int cc = F.tid & 31, kg = F.tid >> 5;
        for (int q = F.bid; q < 384; q += F.G) {
            const int l = q / 192, n0 = (q % 192) * 32;
            const float* wp = ada_w + (size_t)l * 1024 * 6144 + n0 + cc;
            float a[9];
#pragma unroll
            for (int b = 0; b < 9; ++b) a[b] = 0.f;
            for (int j = 0; j < 64; ++j) { const int k = kg + 16 * j; const float wv = wp[(size_t)k * 6144];
#pragma unroll
                for (int b = 0; b < 9; ++b) a[b] += sc[b * 1024 + k] * wv; }
#pragma unroll
            for (int b = 0; b < 9; ++b) red[(kg * 9 + b) * 32 + cc] = a[b];
            __syncthreads();
            if (F.tid < 288) { const int b = F.tid >> 5; float s = ada_b[l * 6144 + n0 + cc];
#pragma unroll
                for (int g = 0; g < 16; ++g) s += red[(g * 9 + b) * 32 + cc];
                MOD[((size_t)l * 9 + b) * 6144 + n0 + cc] = s; }
            __syncthreads();
        }
    }
    for (int q = F.bid; q < 1088; q += F.G) {
        const int ntile = q >> 4, kt = q & 15, n0 = ntile * 64; int nv = NPROJ - n0; nv = nv < 0 ? 0 : (nv > 64 ? 64 : nv);
        transpose_tile(args, F, args.in[8] + (size_t)(kt * 64) * NPROJ + n0, NPROJ, nv, (bf16_t*)(F.ws + WS_WINA) + (size_t)n0 * 1024 + kt * 64, 1024);
    }
}
__device__ __forceinline__ void p_transposes(const Args& args, const Frame& F, const int first, const int stride) {
    const int NSMALL = 1280, NMOE = 2 * NE * 384;
    for (int q = first; q < NSMALL + NMOE; q += stride) {
        if (q < 256) {
            const int ntile = q >> 4, kt = q & 15;
            transpose_tile(args, F, args.in[13] + (size_t)(kt * 64) * D + ntile * 64, D, 64, (bf16_t*)(F.ws + WS_WOUTA) + (size_t)(ntile * 64) * 1024 + kt * 64, 1024);
        } else if (q < 1024) {
            const int qq = q - 256, ntile = qq >> 4, kt = qq & 15, nd = ntile * 64, j = nd >> 8, w = nd & 255;
            const int ns = (j < 4) ? nd : ((w < 128) ? (1024 + 128 * (j - 4) + w) : (2048 + 128 * (j - 4) + (w - 128)));
            transpose_tile(args, F, args.in[14] + (size_t)(kt * 64) * 3072 + ns, 3072, 64, (bf16_t*)(F.ws + WS_WINB) + (size_t)nd * 1024 + kt * 64, 1024);
        } else if (q < 1280) {
            const int qq = q - 1024, ntile = qq >> 4, kt = qq & 15;
            transpose_tile(args, F, args.in[16] + (size_t)(kt * 64) * D + ntile * 64, D, 64, (bf16_t*)(F.ws + WS_WOUTB) + (size_t)(ntile * 64) * 1024 + kt * 64, 1024);
        } else {
            const int qq = q - NSMALL, le = qq / 384, r = qq % 384;
            if (r < 256) {
                const int ntile = r >> 4, kt = r & 15, nd = ntile * 64, j = nd >> 8, w = nd & 255;
                const float* src = (w < 128) ? args.in[19] : args.in[20]; const int ns = 128 * j + (w & 127);
                transpose_tile_fp8(args, F, src + (size_t)le * 1024 * 512 + (size_t)(kt * 64) * 512 + ns, 512, (unsigned char*)(F.ws + WS_W13) + ((size_t)le * 1024 + nd) * 1024 + kt * 64, 1024, W13_SCALE);
            } else {
                const int rr = r - 256, ntile = rr >> 3, kt = rr & 7;
                transpose_tile_fp8(args, F, args.in[21] + (size_t)le * 512 * 1024 + (size_t)(kt * 64) * 1024 + ntile * 64, 1024, (unsigned char*)(F.ws + WS_W2) + ((size_t)le * 1024 + ntile * 64) * 512 + kt * 64, 512, W2_SCALE);
            }
        }
    }
}

struct TTile { const float* src; int ld; unsigned char* dst; int ldd; int fp8; float sc; };
__device__ __forceinline__ TTile tt_decode(const Args& args, const Frame& F, const int q) {
    TTile t; t.fp8 = 0; t.sc = 1.f;
    if (q < 256) { const int ntile = q >> 4, kt = q & 15;
        t.src = args.in[13] + (size_t)(kt * 64) * D + ntile * 64; t.ld = D; t.dst = (unsigned char*)((bf16_t*)(F.ws + WS_WOUTA) + (size_t)(ntile * 64) * 1024 + kt * 64); t.ldd = 2048;
    } else if (q < 1024) { const int qq = q - 256, ntile = qq >> 4, kt = qq & 15, nd = ntile * 64, j = nd >> 8, w = nd & 255;
        const int ns = (j < 4) ? nd : ((w < 128) ? (1024 + 128 * (j - 4) + w) : (2048 + 128 * (j - 4) + (w - 128)));
        t.src = args.in[14] + (size_t)(kt * 64) * 3072 + ns; t.ld = 3072; t.dst = (unsigned char*)((bf16_t*)(F.ws + WS_WINB) + (size_t)nd * 1024 + kt * 64); t.ldd = 2048;
    } else if (q < 1280) { const int qq = q - 1024, ntile = qq >> 4, kt = qq & 15;
        t.src = args.in[16] + (size_t)(kt * 64) * D + ntile * 64; t.ld = D; t.dst = (unsigned char*)((bf16_t*)(F.ws + WS_WOUTB) + (size_t)(ntile * 64) * 1024 + kt * 64); t.ldd = 2048;
    } else { const int qq = q - 1280, le = qq / 384, r = qq % 384; t.fp8 = 1;
        if (r < 256) { const int ntile = r >> 4, kt = r & 15, nd = ntile * 64, j = nd >> 8, w = nd & 255;
            const float* src = (w < 128) ? args.in[19] : args.in[20]; const int ns = 128 * j + (w & 127);
            t.src = src + (size_t)le * 1024 * 512 + (size_t)(kt * 64) * 512 + ns; t.ld = 512; t.dst = (unsigned char*)(F.ws + WS_W13) + ((size_t)le * 1024 + nd) * 1024 + kt * 64; t.ldd = 1024; t.sc = W13_SCALE;
        } else { const int rr = r - 256, ntile = rr >> 3, kt = rr & 7;
            t.src = args.in[21] + (size_t)le * 512 * 1024 + (size_t)(kt * 64) * 1024 + ntile * 64; t.ld = 1024; t.dst = (unsigned char*)(F.ws + WS_W2) + ((size_t)le * 1024 + ntile * 64) * 512 + kt * 64; t.ldd = 512; t.sc = W2_SCALE; }
    }
    return t;
}
constexpr int TT_TILES = 1280 + 2 * NE * 384;

__device__ __forceinline__ void p_qkvprep(const Args& args, const Frame& F) {
    {
        float* GBw = (float*)(F.ws + WS_GB);
        for (int w = F.bid * NTHREADS + F.tid; w < (MROWS / 64) * 16; w += F.G * NTHREADS) {
            const int chunk = w >> 4, dh = w & 15; const bool bwd = dh >= 8;
            const float neg_a = -__expf(args.in[10][dh]), dtb = args.in[11][dh];
            float* p = GBw + (size_t)chunk * 64 * 32 + dh;
            float acc = 0.f;
            for (int k0 = 0; k0 < 64; k0 += 8) {
                float av[8], bv[8];
#pragma unroll
                for (int k = 0; k < 8; ++k) { const int t = bwd ? (63 - k0 - k) : (k0 + k); av[k] = p[t * 32 + 16]; bv[k] = p[t * 32]; }
#pragma unroll
                for (int k = 0; k < 8; ++k) { const int t = bwd ? (63 - k0 - k) : (k0 + k);
                    const float xx = av[k] + dtb; const float sp = xx > 15.f ? xx : __logf(1.0f + __expf(xx));
                    acc += neg_a * sp; p[t * 32 + 16] = acc; p[t * 32] = __builtin_amdgcn_rcpf(1.0f + __expf(-bv[k])); }
            }
        }
    }
    bf16_t* QKVP = (bf16_t*)(F.ws + WS_QKVP); const bf16_t* HALO = (const bf16_t*)(F.ws + WS_HALO); const float* conv_a = args.in[9];
    const int nwv = F.G * 8;
    for (int u = F.bid * 8 + F.wave; u < (MROWS / 256) * 6; u += nwv) {
        const int tile = u / 6, slab = u % 6; const int col = slab * 512 + 8 * F.lane; const int mm = col >> 10;
        const bool lat = tile < T / 256; const bool sstart = lat ? ((tile & 31) == 0) : true, send = lat ? ((tile & 31) == 31) : true;
        float w0[8], w1[8], w2[8];
#pragma unroll
        for (int j = 0; j < 8; ++j) { w0[j] = conv_a[col + j]; w1[j] = conv_a[3072 + col + j]; w2[j] = conv_a[6144 + col + j]; }
        bf16_t* base = QKVP + (size_t)tile * 256 * (3 * D) + col;
        const u32x4 zero4 = (u32x4){0u, 0u, 0u, 0u};
        u32x4 prev = sstart ? zero4 : *(const u32x4*)(HALO + ((size_t)(tile - 1) * 2 + 1) * (3 * D) + col);
        u32x4 cur = *(const u32x4*)(base);
        const u32x4 after = send ? zero4 : *(const u32x4*)(HALO + ((size_t)(tile + 1) * 2) * (3 * D) + col);
        for (int t0 = 0; t0 < 256; t0 += 8) {
            u32x4 nx[8];
#pragma unroll
            for (int k = 0; k < 8; ++k) { const int t = t0 + k + 1; nx[k] = (t < 256) ? *(const u32x4*)(base + (size_t)t * (3 * D)) : after; }
#pragma unroll
            for (int k = 0; k < 8; ++k) {
                float y[8];
#pragma unroll
                for (int j = 0; j < 4; ++j) {
                    y[2 * j] = silu_f(w0[2 * j] * bflo(prev[j]) + w1[2 * j] * bflo(cur[j]) + w2[2 * j] * bflo(nx[k][j]));
                    y[2 * j + 1] = silu_f(w0[2 * j + 1] * bfhi(prev[j]) + w1[2 * j + 1] * bfhi(cur[j]) + w2[2 * j + 1] * bfhi(nx[k][j])); }
                if (mm < 2) {
                    float ss = 0.f;
#pragma unroll
                    for (int j = 0; j < 8; ++j) ss += y[j] * y[j];
                    ss = row_sum16(ss);
                    const float sc = rsqrtf(ss + EPS) * (mm == 0 ? 0.08838834764831845f : 1.0f);
#pragma unroll
                    for (int j = 0; j < 8; ++j) y[j] *= sc;
                }
                u32x4 w; w.x = pk_bf16(y[0], y[1]); w.y = pk_bf16(y[2], y[3]); w.z = pk_bf16(y[4], y[5]); w.w = pk_bf16(y[6], y[7]);
                *(u32x4*)(base + (size_t)(t0 + k) * (3 * D)) = w;
                prev = cur; cur = nx[k];
            }
        }
    }
}

__device__ __forceinline__ void p_modulate0(const Args& args, const Frame& F) {
    const float* x = args.in[0]; const float* ctx = args.in[2]; const float* nrm = args.in[6];
    const float* MOD = (const float*)(F.ws + WS_MOD);
    bf16_t* Hh = (bf16_t*)(F.ws + WS_A1);
    const int nw = F.G * 8, gw = F.bid * 8 + F.wave, per = (MROWS + nw - 1) / nw;
    const int r0 = gw * per, r1 = (r0 + per) < MROWS ? (r0 + per) : MROWS;
    if (r0 >= r1) return;
    f32x4 gv[4];
#pragma unroll
    for (int j = 0; j < 4; ++j) gv[j] = *(const f32x4*)(nrm + 4 * F.lane + 256 * j);
    f32x4 v[4], vnx[4];
#define P1_LOAD(dst, r_) do { const int rr_ = (r_); const float* src_ = (rr_ < T) ? (x + (size_t)rr_ * D) : (ctx + (size_t)(rr_ - T) * D); \
        _Pragma("unroll") for (int j = 0; j < 4; ++j) dst[j] = *(const f32x4*)(src_ + 4 * F.lane + 256 * j); } while (0)
    P1_LOAD(v, r0);
    int cur_md = -1; f32x4 av[4], cv[4];
    for (int r = r0; r < r1; ++r) {
        if (r + 1 < r1) P1_LOAD(vnx, r + 1);
        const int mdi = (r < T) ? (r / SEQ) : 8;
        if (mdi != cur_md) { cur_md = mdi; const float* md = MOD + (size_t)mdi * 6144;
#pragma unroll
            for (int j = 0; j < 4; ++j) { const int c = 4 * F.lane + 256 * j; av[j] = gv[j] * (*(const f32x4*)(md + 1024 + c) + 1.0f); cv[j] = *(const f32x4*)(md + c); } }
        float ss = 0.f;
#pragma unroll
        for (int j = 0; j < 4; ++j) ss += v[j][0] * v[j][0] + v[j][1] * v[j][1] + v[j][2] * v[j][2] + v[j][3] * v[j][3];
        ss = wave_sum(ss);
        const float rs = rsqrtf(ss * (1.0f / D) + EPS);
#pragma unroll
        for (int j = 0; j < 4; ++j) { const int c = 4 * F.lane + 256 * j;
            const f32x4 o = v[j] * rs * av[j] + cv[j];
            u32x2 w; w.x = pk_bf16(o[0], o[1]); w.y = pk_bf16(o[2], o[3]); *(u32x2*)(Hh + (size_t)r * D + c) = w; }
#pragma unroll
        for (int j = 0; j < 4; ++j) v[j] = vnx[j];
    }
#undef P1_LOAD
}

__device__ __forceinline__ void p_finish(const Args& args, const Frame& F) {
    const bf16_t* OFp = (const bf16_t*)F.out; const bf16_t* OBp = OFp + (size_t)T * D; const bf16_t* Z = (const bf16_t*)(F.ws + WS_Z);
    const float* onorm = args.in[12]; bf16_t* Y = (bf16_t*)(F.ws + WS_A1);
    const int nw = F.G * 8, gw = F.bid * 8 + F.wave, per = (T + nw - 1) / nw;
    const int r0 = gw * per, r1 = (r0 + per) < T ? (r0 + per) : T;
    if (r0 >= r1) return;
    float on[16];
#pragma unroll
    for (int j = 0; j < 16; ++j) on[j] = onorm[(16 * F.lane + j) & 127];
    u32x4 c[6], n[6];
#define P5_LOAD(dst, r_) do { const size_t off_ = (size_t)(r_) * D + 16 * F.lane; dst[0] = *(const u32x4*)(OFp + off_); dst[1] = *(const u32x4*)(OFp + off_ + 8); \
        dst[2] = *(const u32x4*)(OBp + off_); dst[3] = *(const u32x4*)(OBp + off_ + 8); dst[4] = *(const u32x4*)(Z + off_); dst[5] = *(const u32x4*)(Z + off_ + 8); } while (0)
    P5_LOAD(c, r0);
    for (int r = r0; r < r1; ++r) {
        if (r + 1 < r1) P5_LOAD(n, r + 1);
        const size_t off = (size_t)r * D + 16 * F.lane;
        float o[16], zz[16]; float ss = 0.f;
#pragma unroll
        for (int j = 0; j < 4; ++j) {
            o[2 * j] = bflo(c[0][j]) + bflo(c[2][j]); o[2 * j + 1] = bfhi(c[0][j]) + bfhi(c[2][j]);
            o[8 + 2 * j] = bflo(c[1][j]) + bflo(c[3][j]); o[8 + 2 * j + 1] = bfhi(c[1][j]) + bfhi(c[3][j]);
            zz[2 * j] = bflo(c[4][j]); zz[2 * j + 1] = bfhi(c[4][j]); zz[8 + 2 * j] = bflo(c[5][j]); zz[8 + 2 * j + 1] = bfhi(c[5][j]); }
#pragma unroll
        for (int j = 0; j < 16; ++j) ss += o[j] * o[j];
        ss += __shfl_xor(ss, 1); ss += __shfl_xor(ss, 2); ss += __shfl_xor(ss, 4);
        const float rs = rsqrtf(ss * (1.0f / HD) + EPS);
        float y[16];
#pragma unroll
        for (int j = 0; j < 16; ++j) y[j] = o[j] * rs * on[j] * silu_f(zz[j]);
        u32x4 w0, w1; w0.x = pk_bf16(y[0], y[1]); w0.y = pk_bf16(y[2], y[3]); w0.z = pk_bf16(y[4], y[5]); w0.w = pk_bf16(y[6], y[7]);
        w1.x = pk_bf16(y[8], y[9]); w1.y = pk_bf16(y[10], y[11]); w1.z = pk_bf16(y[12], y[13]); w1.w = pk_bf16(y[14], y[15]);
        *(u32x4*)(Y + off) = w0; *(u32x4*)(Y + off + 8) = w1;
#pragma unroll
        for (int j = 0; j < 6; ++j) c[j] = n[j];
    }
#undef P5_LOAD
}

__device__ __forceinline__ void p_ffn_route(const Args& args, const Frame& F, const int l) {
    const bf16_t* X = (const bf16_t*)(F.ws + WS_X); const float* nrm = args.in[7] + l * D; const float* MOD = (const float*)(F.ws + WS_MOD) + (size_t)l * 9 * 6144;
    const float* rg = args.in[17] + (size_t)l * D * 4; const float* re = args.in[18] + (size_t)l * D * NE;
    unsigned char* Hf = (unsigned char*)(F.ws + WS_A1);
    int* REID = (int*)(F.ws + WS_REID); float* RWT = (float*)(F.ws + WS_RWT); int* RRANK = (int*)(F.ws + WS_RRANK); int* TCNT = (int*)(F.ws + WS_META);
    LAS float* RT = (LAS float*)F.lds;
    LAS float* AB = (LAS float*)(F.lds + 36 * 1024 * 4);
    LAS int* cntl = (LAS int*)(F.lds + 38 * 1024 * 4);
    for (int i = F.tid; i < 1024 * 4; i += NTHREADS) { const int k = i >> 2, g = i & 3; RT[g * 1024 + k] = rg[i]; }
    for (int i = F.tid; i < 1024 * NE; i += NTHREADS) { const int k = i >> 5, e = i & 31; RT[(4 + e) * 1024 + k] = re[i]; }
    const int tq = F.lane >> 4, j4 = 4 * (F.lane & 15);
    for (int tile = F.bid; tile < T / 256; tile += F.G) {
        __syncthreads();
        const float* md = MOD + (size_t)((tile * 256) / SEQ) * 6144;
        for (int i = F.tid; i < 1024; i += NTHREADS) { AB[i] = nrm[i] * (md[4 * 1024 + i] + 1.0f); AB[1024 + i] = md[3 * 1024 + i]; }
        if (F.tid < 32) cntl[F.tid] = 0;
        __syncthreads();
#pragma unroll 1
        for (int qd = 0; qd < 8; ++qd) {
            const int r = tile * 256 + F.wave * 32 + qd * 4 + tq;
            const bf16_t* src = X + (size_t)r * D + j4;
            f32x4 v[16]; float ss = 0.f;
#pragma unroll
            for (int m = 0; m < 16; ++m) { const u32x2 t = *(const u32x2*)(src + 64 * m); v[m] = (f32x4){bflo(t.x), bfhi(t.x), bflo(t.y), bfhi(t.y)}; ss += v[m][0] * v[m][0] + v[m][1] * v[m][1] + v[m][2] * v[m][2] + v[m][3] * v[m][3]; }
            ss = row_sum16(ss);
            const float rs = rsqrtf(ss * (1.0f / D) + EPS);
            unsigned char* hp = Hf + (size_t)r * D + j4;
#pragma unroll
            for (int m = 0; m < 16; ++m) { const f32x4 a = *(const LAS f32x4*)(AB + j4 + 64 * m), c = *(const LAS f32x4*)(AB + 1024 + j4 + 64 * m);
                v[m] = v[m] * rs * a + c;
                *(unsigned*)(hp + 64 * m) = pk_fp8x4(v[m][0], v[m][1], v[m][2], v[m][3]); }
            float lg[4];
#pragma unroll
            for (int g = 0; g < 4; ++g) { float s = 0.f; const LAS float* wp = RT + g * 1024 + j4;
#pragma unroll
                for (int m = 0; m < 16; ++m) { const f32x4 w = *(const LAS f32x4*)(wp + 64 * m); s += v[m][0] * w[0] + v[m][1] * w[1] + v[m][2] * w[2] + v[m][3] * w[3]; }
                lg[g] = row_sum16(s); }
            int gi = 0; float lm = lg[0];
#pragma unroll
            for (int g = 1; g < 4; ++g) if (lg[g] > lm) { lm = lg[g]; gi = g; }
            float den = 0.f;
#pragma unroll
            for (int g = 0; g < 4; ++g) den += __expf(lg[g] - lm);
            const float pg = 1.0f / den;
            float le[8];
            const LAS float* we = RT + (4 + gi * 8) * 1024 + j4;
#pragma unroll
            for (int e = 0; e < 8; ++e) { float s = 0.f;
#pragma unroll
                for (int m = 0; m < 16; ++m) { const f32x4 w = *(const LAS f32x4*)(we + e * 1024 + 64 * m); s += v[m][0] * w[0] + v[m][1] * w[1] + v[m][2] * w[2] + v[m][3] * w[3]; }
                le[e] = row_sum16(s); }
            int i1 = 0; float m1 = le[0];
#pragma unroll
            for (int e = 1; e < 8; ++e) if (le[e] > m1) { m1 = le[e]; i1 = e; }
            int i2 = -1; float m2 = -3.0e38f;
#pragma unroll
            for (int e = 0; e < 8; ++e) if (e != i1 && le[e] > m2) { m2 = le[e]; i2 = e; }
            const float ex = __expf(m2 - m1); const float w1 = pg / (1.0f + ex), w2 = pg * ex / (1.0f + ex);
            if ((F.lane & 15) == 0) {
                const int e1 = gi * 8 + i1, e2 = gi * 8 + i2;
                const int k1 = __hip_atomic_fetch_add(cntl + e1, 1, __ATOMIC_RELAXED, __HIP_MEMORY_SCOPE_WORKGROUP); const int k2 = __hip_atomic_fetch_add(cntl + e2, 1, __ATOMIC_RELAXED, __HIP_MEMORY_SCOPE_WORKGROUP);
                REID[2 * r] = e1; REID[2 * r + 1] = e2; RWT[2 * r] = w1; RWT[2 * r + 1] = w2; RRANK[2 * r] = k1; RRANK[2 * r + 1] = k2;
            }
        }
        __syncthreads();
        if (F.tid < 32) TCNT[tile * 32 + F.tid] = cntl[F.tid];
    }
}

__device__ __forceinline__ void p_slots(const Args& args, const Frame& F) {
    const int* TCNT = (const int*)(F.ws + WS_META); int* ESTART = (int*)(F.ws + WS_META) + 256 * 32;
    const int* REID = (const int*)(F.ws + WS_REID); const int* RRANK = (const int*)(F.ws + WS_RRANK); int* POS = (int*)(F.ws + WS_POS); int* ROWTOK = (int*)(F.ws + WS_ROWTOK);
    LAS int* tc = (LAS int*)F.lds;
    LAS int* part = tc + 256 * 32;
    LAS int* tot = part + 16 * 32;
    LAS int* sp = tot + 32;
    for (int i = F.tid; i < 256 * 32; i += NTHREADS) tc[i] = TCNT[i];
    __syncthreads();
    const int e = F.tid & 31, pt = F.tid >> 5;
    { int s = 0; for (int j = 0; j < 16; ++j) { const int v = tc[(pt * 16 + j) * 32 + e]; tc[(pt * 16 + j) * 32 + e] = s; s += v; } part[pt * 32 + e] = s; }
    __syncthreads();
    if (F.tid < 32) { int s = 0; for (int j = 0; j < 16; ++j) { const int v = part[j * 32 + e]; part[j * 32 + e] = s; s += v; } tot[e] = s; }
    __syncthreads();
    if (F.tid == 0) { int s = 0; for (int j = 0; j < 32; ++j) { sp[j] = s; s += (tot[j] + 255) & ~255; } sp[32] = s; }
    __syncthreads();
    if (F.bid == 0 && F.tid < 33) ESTART[F.tid] = sp[F.tid] >> 8;
    for (int tile = F.bid; tile < T / 256; tile += F.G) {
        const int p = tile * 512 + F.tid; const int ee = REID[p];
        const int slot = sp[ee] + part[(tile >> 4) * 32 + ee] + tc[tile * 32 + ee] + RRANK[p];
        POS[p] = slot; ROWTOK[slot] = p >> 1;
    }
    for (int ee = F.bid; ee < NE; ee += F.G) { const int a = sp[ee] + tot[ee], b = sp[ee + 1]; for (int s = a + F.tid; s < b; s += NTHREADS) ROWTOK[s] = 0; }
}

template <bool FINAL>
__device__ __forceinline__ void p_combine(const Args& args, const Frame& F, const int l) {
    bf16_t* X = (bf16_t*)(F.ws + WS_X); float* OUT = F.out; const unsigned char* YB = (const unsigned char*)(F.ws + WS_YB); const int* POS = (const int*)(F.ws + WS_POS); const float* RWT = (const float*)(F.ws + WS_RWT);
    const float* MODl = (const float*)(F.ws + WS_MOD) + (size_t)l * 9 * 6144;
    const float* MODn = (const float*)(F.ws + WS_MOD) + (size_t)(l + 1) * 9 * 6144;
    const float* nrm = FINAL ? args.in[22] : (args.in[6] + (l + 1) * D);
    bf16_t* Hh = (bf16_t*)(F.ws + WS_A1);
    const int nw = F.G * 8, gw = F.bid * 8 + F.wave, per = (T + nw - 1) / nw;
    const int r0 = gw * per, r1 = (r0 + per) < T ? (r0 + per) : T;
    if (r0 >= r1) return;
    f32x4 gv[4];
#pragma unroll
    for (int j = 0; j < 4; ++j) gv[j] = *(const f32x4*)(nrm + 4 * F.lane + 256 * j);
    u32x2 xc[4], xn[4]; unsigned yac[4], ybc[4], yan[4], ybn[4]; float w0c, w1c, w0n = 0.f, w1n = 0.f;
#define CB_LOAD(xd, yad, ybd, w0d, w1d, r_) do { const int rr_ = (r_); const int p0_ = POS[2 * rr_], p1_ = POS[2 * rr_ + 1]; w0d = RWT[2 * rr_] * (1.0f / YB_SCALE); w1d = RWT[2 * rr_ + 1] * (1.0f / YB_SCALE); \
        _Pragma("unroll") for (int j = 0; j < 4; ++j) { const int c_ = 4 * F.lane + 256 * j; xd[j] = *(const u32x2*)(X + (size_t)rr_ * D + c_); \
            yad[j] = *(const unsigned*)(YB + (size_t)p0_ * D + c_); ybd[j] = *(const unsigned*)(YB + (size_t)p1_ * D + c_); } } while (0)
    CB_LOAD(xc, yac, ybc, w0c, w1c, r0);
    int cur_b = -1; f32x4 gtv[4], av[4], cv[4];
    for (int r = r0; r < r1; ++r) {
        if (r + 1 < r1) CB_LOAD(xn, yan, ybn, w0n, w1n, r + 1);
        const int b = r / SEQ;
        if (b != cur_b) { cur_b = b; const float* gt = MODl + (size_t)b * 6144 + 5 * 1024; const float* md = MODn + (size_t)b * 6144;
#pragma unroll
            for (int j = 0; j < 4; ++j) { const int c = 4 * F.lane + 256 * j; gtv[j] = *(const f32x4*)(gt + c);
                if constexpr (!FINAL) { av[j] = gv[j] * (*(const f32x4*)(md + 1024 + c) + 1.0f); cv[j] = *(const f32x4*)(md + c); } } }
        bf16_t* xp = X + (size_t)r * D; float* op = OUT + (size_t)r * D;
        f32x4 v[4]; float ss = 0.f;
#pragma unroll
        for (int j = 0; j < 4; ++j) {
            f32x4 xv = (f32x4){bflo(xc[j].x), bfhi(xc[j].x), bflo(xc[j].y), bfhi(xc[j].y)};
            const f32x2 ya0 = __builtin_amdgcn_cvt_pk_f32_fp8((int)yac[j], false), ya1 = __builtin_amdgcn_cvt_pk_f32_fp8((int)yac[j], true), yb0 = __builtin_amdgcn_cvt_pk_f32_fp8((int)ybc[j], false), yb1 = __builtin_amdgcn_cvt_pk_f32_fp8((int)ybc[j], true);
            f32x4 m; m[0] = w0c * ya0[0] + w1c * yb0[0]; m[1] = w0c * ya0[1] + w1c * yb0[1]; m[2] = w0c * ya1[0] + w1c * yb1[0]; m[3] = w0c * ya1[1] + w1c * yb1[1];
            xv = xv + gtv[j] * m; v[j] = xv;
            ss += xv[0] * xv[0] + xv[1] * xv[1] + xv[2] * xv[2] + xv[3] * xv[3]; }
        ss = wave_sum(ss);
        const float rs = rsqrtf(ss * (1.0f / D) + EPS);
#pragma unroll
        for (int j = 0; j < 4; ++j) { const int c = 4 * F.lane + 256 * j;
            if constexpr (FINAL) { *(f32x4*)(op + c) = v[j] * rs * gv[j]; }
            else { u32x2 xw; xw.x = pk_bf16(v[j][0], v[j][1]); xw.y = pk_bf16(v[j][2], v[j][3]); *(u32x2*)(xp + c) = xw;
                const f32x4 o = v[j] * rs * av[j] + cv[j];
                u32x2 w; w.x = pk_bf16(o[0], o[1]); w.y = pk_bf16(o[2], o[3]); *(u32x2*)(Hh + (size_t)r * D + c) = w; } }
#pragma unroll
        for (int j = 0; j < 4; ++j) { xc[j] = xn[j]; yac[j] = yan[j]; ybc[j] = ybn[j]; }
        w0c = w0n; w1c = w1n;
    }
#undef CB_LOAD
}

__device__ __forceinline__ void p_convgrid(const Args& args, const Frame& F) {
    const bf16_t* GBp = (const bf16_t*)(F.ws + WS_GATEB); const bf16_t* U = (const bf16_t*)(F.ws + WS_U); bf16_t* YY = (bf16_t*)(F.ws + WS_YY);
    const float* cw = args.in[15];
    const int nw = F.G * 8, gw = F.bid * 8 + F.wave, per = (T + nw - 1) / nw;
    const int r0 = gw * per, r1 = (r0 + per) < T ? (r0 + per) : T;
    float w0[16], w1[16], w2[16];
#pragma unroll
    for (int j = 0; j < 16; ++j) { w0[j] = cw[16 * F.lane + j]; w1[j] = cw[1024 + 16 * F.lane + j]; w2[j] = cw[2048 + 16 * F.lane + j]; }
    const bool horiz = F.lane < 32; const int dstep = horiz ? 1 : 64;
    constexpr int RB = 4;
    for (int rb = r0; rb < r1; rb += RB) {
        u32x4 c0[RB], c1[RB], m0[RB], m1[RB], q0[RB], q1[RB], g0[RB], g1[RB];
        const u32x4 z = (u32x4){0u, 0u, 0u, 0u};
#pragma unroll
        for (int k = 0; k < RB; ++k) {
            const int r = rb + k; const bool ok = r < r1; const int rr = ok ? r : r0;
            const int t = rr % SEQ, gc = t & 63, gr = t >> 6;
            const bool hm = horiz ? (gc > 0) : (gr > 0), hp = horiz ? (gc < 63) : (gr < 127);
            const size_t off = (size_t)rr * D + 16 * F.lane;
            c0[k] = *(const u32x4*)(U + off); c1[k] = *(const u32x4*)(U + off + 8);
            m0[k] = hm ? *(const u32x4*)(U + off - (size_t)dstep * D) : z; m1[k] = hm ? *(const u32x4*)(U + off - (size_t)dstep * D + 8) : z;
            q0[k] = hp ? *(const u32x4*)(U + off + (size_t)dstep * D) : z; q1[k] = hp ? *(const u32x4*)(U + off + (size_t)dstep * D + 8) : z;
            g0[k] = *(const u32x4*)(GBp + off); g1[k] = *(const u32x4*)(GBp + off + 8);
        }
#pragma unroll
        for (int k = 0; k < RB; ++k) {
            const int r = rb + k; if (r >= r1) break;
            const size_t off = (size_t)r * D + 16 * F.lane;
            float y[16];
#pragma unroll
            for (int j = 0; j < 4; ++j) {
                y[2 * j]         = bflo(g0[k][j]) * (w0[2 * j] * bflo(m0[k][j]) + w1[2 * j] * bflo(c0[k][j]) + w2[2 * j] * bflo(q0[k][j]));
                y[2 * j + 1]     = bfhi(g0[k][j]) * (w0[2 * j + 1] * bfhi(m0[k][j]) + w1[2 * j + 1] * bfhi(c0[k][j]) + w2[2 * j + 1] * bfhi(q0[k][j]));
                y[8 + 2 * j]     = bflo(g1[k][j]) * (w0[8 + 2 * j] * bflo(m1[k][j]) + w1[8 + 2 * j] * bflo(c1[k][j]) + w2[8 + 2 * j] * bflo(q1[k][j]));
                y[8 + 2 * j + 1] = bfhi(g1[k][j]) * (w0[8 + 2 * j + 1] * bfhi(m1[k][j]) + w1[8 + 2 * j + 1] * bfhi(c1[k][j]) + w2[8 + 2 * j + 1] * bfhi(q1[k][j])); }
            u32x4 o0, o1; o0.x = pk_bf16(y[0], y[1]); o0.y = pk_bf16(y[2], y[3]); o0.z = pk_bf16(y[4], y[5]); o0.w = pk_bf16(y[6], y[7]);
            o1.x = pk_bf16(y[8], y[9]); o1.y = pk_bf16(y[10], y[11]); o1.z = pk_bf16(y[12], y[13]); o1.w = pk_bf16(y[14], y[15]);
            *(u32x4*)(YY + off) = o0; *(u32x4*)(YY + off + 8) = o1;
        }
    }
}

namespace scan {
constexpr int PQ = 136, PT = 72, PU = 68;
constexpr int POS = 72;
constexpr int PV = 80;
constexpr int O_Q = 0, O_K = 34816, O_V = 69632, O_WT = 79872, O_UT = 98304, O_QK = 107008, O_NLF = 125440, O_DTF = 128512, O_TAB = 134656, O_TT = 137216, O_OS = 153856, LDS_END = 163072;
constexpr int IMG = 17408, QKB = 9216, TABB = 1280;
typedef float f32x16 __attribute__((ext_vector_type(16)));
__device__ __forceinline__ f32x4 mfma32(const bf16x8 a, const bf16x8 b, const f32x4 c) { return __builtin_amdgcn_mfma_f32_16x16x32_bf16(a, b, c, 0, 0, 0); }
__device__ __forceinline__ f32x4 mfma16(const bf16x4 a, const bf16x4 b, const f32x4 c) { return __builtin_amdgcn_mfma_f32_16x16x16bf16_1k(a, b, c, 0, 0, 0); }
__device__ __forceinline__ f32x16 mfmaL(const bf16x8 a, const bf16x8 b, const f32x16 c) { return __builtin_amdgcn_mfma_f32_32x32x16_bf16(a, b, c, 0, 0, 0); }
__device__ __forceinline__ bf16x4 ld8(const LAS bf16_t* p) { return *(const volatile LAS bf16x4*)p; }
__device__ __forceinline__ bf16x4 trd(const LAS bf16_t* p) { return __builtin_amdgcn_ds_read_tr16_b64_v4i16((LAS bf16x4*)p); }
__device__ __forceinline__ bf16x8 packL(const f32x16 x, const int s2) {
    return s2 == 0 ? pack8(__builtin_shufflevector(x, x, 0, 1, 2, 3), __builtin_shufflevector(x, x, 4, 5, 6, 7)) : pack8(__builtin_shufflevector(x, x, 8, 9, 10, 11), __builtin_shufflevector(x, x, 12, 13, 14, 15));
}
}

template <int CH0, int CH1> __device__ __forceinline__ void scan_b3(const Frame& F, const int rt, LAS bf16_t* Vs, LAS bf16_t* Kp, LAS bf16_t* UT, LAS bf16_t* WTp, LAS bf16x4* NLF, LAS bf16x4* DTF) {
    using namespace scan;
#define SCHED() __builtin_amdgcn_sched_barrier(0)
                    int l2 = F.lane; asm volatile("" : "+v"(l2));
                    const int n16 = l2 & 15, g4 = l2 >> 4; const int lane = l2;
                    const int trl = (4 * g4 + (n16 >> 2)) * PQ + 4 * (n16 & 3), trv = (4 * g4 + (n16 >> 2)) * PV + 4 * (n16 & 3);
                    bf16x4 nl[6], dt[4], du[4], dw[4];
#pragma unroll
                    for (int bb = 0; bb < 4; ++bb) { dt[bb] = DTF[bb * 64 + lane]; du[bb] = DTF[(4 + bb) * 64 + lane]; dw[bb] = DTF[(8 + bb) * 64 + lane]; }
#pragma unroll
                    for (int k = 0; k < 6; ++k) nl[k] = NLF[k * 64 + lane];
                    bf16x4 rr[4][4];
#pragma unroll
                    for (int ch = CH0; ch < CH1; ++ch)
#pragma unroll
                        for (int bb = 0; bb < 4; ++bb) rr[ch][bb] = trd((ch < 2 ? Vs + trv + 16 * bb * PV : Kp + trl + 16 * bb * PQ) + 32 * rt + 16 * (ch & 1));
                    SCHED();
                    bf16x4 xb[4][4];
                    const f32x4 z4 = (f32x4){0.f, 0.f, 0.f, 0.f};
#pragma unroll
                    for (int bb = 0; bb < 4; ++bb) {
#pragma unroll
                        for (int ch = CH0; ch < CH1; ++ch) {
                            f32x4 x = mfma16(ch < 2 ? du[bb] : dw[bb], rr[ch][bb], z4);
                            if (bb > 0) {
                                f32x4 y = z4;
#pragma unroll
                                for (int kb = 0; kb < 4; ++kb) if (kb < bb) y = mfma16(nl[bb * (bb - 1) / 2 + kb], xb[ch][kb], y);
                                x = mfma16(dt[bb], pack4(y), x);
                            }
                            xb[ch][bb] = pack4(x);
                            LAS bf16_t* dstp = (ch < 2 ? UT + (32 * rt + 16 * (ch & 1) + n16) * PU : WTp + (32 * rt + 16 * (ch & 1) + n16) * PT) + 16 * bb + 4 * g4;
                            *(LAS bf16x4*)dstp = xb[ch][bb];
                        }
                    }

#undef SCHED
}

template <bool DOK, bool DOQ> __device__ __forceinline__ void scan_b1(const Frame& F, const int rt, LAS bf16_t* Kp, LAS bf16_t* Qp, LAS float* Tp, LAS bf16_t* QKs, LAS bf16x4* NLF, LAS bf16x4* DTF) {
    using namespace scan;
#define SCHED() __builtin_amdgcn_sched_barrier(0)
                    int l1 = F.lane; asm volatile("" : "+v"(l1));
                    const int n16 = l1 & 15, g4 = l1 >> 4; const int lane = l1;
                    const LAS bf16_t* kb_ = Kp + n16 * PQ + 8 * g4;
                    const LAS bf16_t* okp = Kp + (16 * rt + n16) * PQ + 8 * g4; const LAS bf16_t* oqp = Qp + (16 * rt + n16) * PQ + 8 * g4;
                    bf16x8 ofk[4], ofq[4];
#pragma unroll
                    for (int s2 = 0; s2 < 4; ++s2) { if (DOK) ofk[s2] = *(const LAS bf16x8*)(okp + 32 * s2); if (DOQ) ofq[s2] = *(const LAS bf16x8*)(oqp + 32 * s2); }
                    f32x4 tg[4];
#pragma unroll
                    for (int t = 0; t < 4; ++t) tg[t] = *(const LAS f32x4*)(Tp + 16 * t + 4 * g4);
                    const f32x4 tbo = *(const LAS f32x4*)(Tp + 64 + 16 * rt + 4 * g4);
                    const float gci = Tp[16 * rt + n16], bei = Tp[64 + 16 * rt + n16];
                    f32x4 aK[4], aQ[4];
#pragma unroll
                    for (int t = 0; t < 4; ++t) { aK[t] = (f32x4){0.f, 0.f, 0.f, 0.f}; aQ[t] = (f32x4){0.f, 0.f, 0.f, 0.f}; }
#pragma unroll
                    for (int th = 0; th < 2; ++th) if (2 * th <= rt) {
                        bf16x8 kf[2][4];
#pragma unroll
                        for (int tt = 0; tt < 2; ++tt)
#pragma unroll
                            for (int s2 = 0; s2 < 4; ++s2) kf[tt][s2] = *(const LAS bf16x8*)(kb_ + 16 * (2 * th + tt) * PQ + 32 * s2);
                        SCHED();
#pragma unroll
                        for (int s2 = 0; s2 < 4; ++s2)
#pragma unroll
                            for (int tt = 0; tt < 2; ++tt) { if (DOK) aK[2 * th + tt] = mfma32(kf[tt][s2], ofk[s2], aK[2 * th + tt]); if (DOQ) aQ[2 * th + tt] = mfma32(kf[tt][s2], ofq[s2], aQ[2 * th + tt]); }
                        SCHED();
                    }
                    LAS bf16_t* qkw = QKs + (16 * rt + n16) * PU + 4 * g4;
#pragma unroll
                    for (int t = 0; t < 4; ++t) {
                        if (t <= rt) {
                            f32x4 dec;
#pragma unroll
                            for (int r = 0; r < 4; ++r) dec[r] = __expf(gci - tg[t][r]);
                            if (DOQ) { f32x4 o;
#pragma unroll
                                for (int r = 0; r < 4; ++r) { const bool ge = (t < rt) || (n16 >= 4 * g4 + r); o[r] = ge ? aQ[t][r] * dec[r] : 0.f; }
                                *(LAS bf16x4*)(qkw + 16 * t) = pack4(o); }
                            if (DOK && t < rt) {
                                f32x4 nl;
#pragma unroll
                                for (int r = 0; r < 4; ++r) nl[r] = -bei * aK[t][r] * dec[r];
                                NLF[(rt * (rt - 1) / 2 + t) * 64 + lane] = pack4(nl);
                            }
                        } else if (DOQ && t == rt + 1 && !(rt & 1)) {
                            *(LAS bf16x4*)(qkw + 16 * t) = (bf16x4){0, 0, 0, 0};
                        }
                    }
                    if (DOK) {
                        const f32x4 g = rt == 0 ? aK[0] : (rt == 1 ? aK[1] : (rt == 2 ? aK[2] : aK[3]));
                        const f32x4 tgo = rt == 0 ? tg[0] : (rt == 1 ? tg[1] : (rt == 2 ? tg[2] : tg[3]));
                        f32x4 Lc, LTc, T1T;
#pragma unroll
                        for (int r = 0; r < 4; ++r) {
                            const int aa = 4 * g4 + r;
                            Lc[r] = (aa > n16) ? tbo[r] * g[r] * __expf(tgo[r] - gci) : 0.f;
                            LTc[r] = (n16 > aa) ? bei * g[r] * __expf(gci - tgo[r]) : 0.f;
                            T1T[r] = ((aa == n16) ? 1.f : 0.f) - LTc[r];
                        }
                        const f32x4 z4 = (f32x4){0.f, 0.f, 0.f, 0.f};
                        const bf16x4 l = pack4(Lc), lt = pack4(LTc);
                        const f32x4 L2 = mfma16(lt, l, z4), L2T = mfma16(l, lt, z4);
                        const bf16x4 l2 = pack4(L2), l2t = pack4(L2T);
                        const f32x4 L4 = mfma16(l2t, l2, z4), L4T = mfma16(l2, l2t, z4);
                        const f32x4 T2T = mfma16(l2, pack4(T1T), T1T);
                        const bf16x4 l4 = pack4(L4), l4t = pack4(L4T);
                        const f32x4 L8 = mfma16(l4t, l4, z4);
                        const f32x4 T3T = mfma16(l4, pack4(T2T), T2T);
                        const f32x4 T4T = mfma16(pack4(L8), pack4(T3T), T3T);
                        DTF[rt * 64 + lane] = pack4(T4T);
                        const f32x4 teo = *(const LAS f32x4*)(Tp + 128 + 16 * rt + 4 * g4);
                        DTF[(4 + rt) * 64 + lane] = pack4(T4T * tbo);
                        DTF[(8 + rt) * 64 + lane] = pack4(T4T * tbo * teo);
                    }

#undef SCHED
}

__device__ __forceinline__ void p_scan(const Args& args, const Frame& F) {
    using namespace scan;
#define SCAN_BAR() do { asm volatile("s_waitcnt lgkmcnt(0)" ::: "memory"); __builtin_amdgcn_s_barrier(); asm volatile("" ::: "memory"); } while (0)
#define SCHED() __builtin_amdgcn_sched_barrier(0)
    const bf16_t* QKV = (const bf16_t*)(F.ws + WS_QKVP); const float* GB = (const float*)(F.ws + WS_GB);
    bf16_t* OFp = (bf16_t*)F.out; bf16_t* OBp = OFp + (size_t)T * D;
    LAS bf16_t* Vs = (LAS bf16_t*)(F.lds + O_V); LAS bf16_t* UT = (LAS bf16_t*)(F.lds + O_UT); LAS bf16_t* WT = (LAS bf16_t*)(F.lds + O_WT);
    LAS bf16x4* NLF = (LAS bf16x4*)(F.lds + O_NLF); LAS bf16x4* DTF = (LAS bf16x4*)(F.lds + O_DTF);
    const int tid = F.tid, wave = F.wave;
    const bool cons = wave < 2, helper = wave >= 2 && wave < 4;
    const int item = F.bid;
    if (item < NB * NH * 4) {
        const int vh = item & 1, dir = (item >> 1) & 1, h = (item >> 2) & 7, b = item >> 5;
        int tidv = F.tid; asm volatile("" : "+v"(tidv));
        const int tq0 = F.bid; const bool args_notr = args.li == 1;
        if (helper) {
            const int ht = tidv - 128;
            LAS float* TT = (LAS float*)(F.lds + O_TT);
            f32x4 tp[8]; TTile tc; bool tvalid = false;
            const int tr0 = ht >> 4, tc4 = (ht & 15) * 4;
            { const int q0 = tq0; if (!args_notr && q0 < TT_TILES) { tc = tt_decode(args, F, q0); tvalid = true;
#pragma unroll
                for (int p = 0; p < 8; ++p) tp[p] = *(const f32x4*)(tc.src + (size_t)(tr0 + 8 * p) * tc.ld + tc4); } }
            if (tvalid) {
#pragma unroll
                for (int p = 0; p < 8; ++p)
#pragma unroll
                    for (int j = 0; j < 4; ++j) TT[(tr0 + 8 * p) * 65 + tc4 + j] = tp[p][j];
            }
            SCAN_BAR();
            for (int s = 0; s <= 132; ++s) {
                const int pb = s & 1;
                LAS bf16_t* Kp = (LAS bf16_t*)(F.lds + O_K + pb * IMG); LAS bf16_t* QKp = (LAS bf16_t*)(F.lds + O_QK + pb * QKB);
                LAS bf16_t* Qp = (LAS bf16_t*)(F.lds + O_Q + pb * IMG); LAS float* Tp = (LAS float*)(F.lds + O_TAB + pb * TABB);
                const TTile tw = tc; const bool wvalid = tvalid;
                if (wvalid) {
                    const int n = ht >> 1, kk = (ht & 1) * 32;
                    float o[32];
#pragma unroll
                    for (int j = 0; j < 32; ++j) o[j] = TT[(kk + j) * 65 + n] * tw.sc;
                    if (tw.fp8) {
#pragma unroll
                        for (int g = 0; g < 2; ++g) { u32x4 w; w.x = pk_fp8x4(o[16 * g], o[16 * g + 1], o[16 * g + 2], o[16 * g + 3]); w.y = pk_fp8x4(o[16 * g + 4], o[16 * g + 5], o[16 * g + 6], o[16 * g + 7]);
                            w.z = pk_fp8x4(o[16 * g + 8], o[16 * g + 9], o[16 * g + 10], o[16 * g + 11]); w.w = pk_fp8x4(o[16 * g + 12], o[16 * g + 13], o[16 * g + 14], o[16 * g + 15]);
                            *(u32x4*)(tw.dst + (size_t)n * tw.ldd + kk + 16 * g) = w; }
                    } else {
#pragma unroll
                        for (int g = 0; g < 4; ++g) { u32x4 w; w.x = pk_bf16(o[8 * g], o[8 * g + 1]); w.y = pk_bf16(o[8 * g + 2], o[8 * g + 3]); w.z = pk_bf16(o[8 * g + 4], o[8 * g + 5]); w.w = pk_bf16(o[8 * g + 6], o[8 * g + 7]);
                            *(u32x4*)(tw.dst + (size_t)n * tw.ldd + (kk + 8 * g) * 2) = w; }
                    }
                }
                { const int qn = tq0 + (s + 1) * F.G; tvalid = !args_notr && s < 132 && qn < TT_TILES;
                  if (tvalid) { tc = tt_decode(args, F, qn);
#pragma unroll
                    for (int p = 0; p < 8; ++p) tp[p] = *(const f32x4*)(tc.src + (size_t)(tr0 + 8 * p) * tc.ld + tc4); } }
                if (s < 132) scan_b1<false, true>(F, wave, Kp, Qp, Tp, QKp, NLF, DTF);
                SCAN_BAR();
                if (s < 132) scan_b3<0, 2>(F, wave - 2, Vs, Kp, UT, WT, NLF, DTF);
                if (tvalid) {
#pragma unroll
                    for (int p = 0; p < 8; ++p)
#pragma unroll
                        for (int j = 0; j < 4; ++j) TT[(tr0 + 8 * p) * 65 + tc4 + j] = tp[p][j];
                }
                SCAN_BAR();
            }
        } else if (cons) {
            f32x16 St[4];
#pragma unroll
            for (int d = 0; d < 4; ++d)
#pragma unroll
                for (int i = 0; i < 16; ++i) St[d][i] = 0.f;
            __builtin_amdgcn_s_setprio(2);
            SCAN_BAR(); SCAN_BAR();
            bf16x8 Sb[4][2];
#pragma unroll
            for (int d = 0; d < 4; ++d) { Sb[d][0] = packL(St[d], 0); Sb[d][1] = packL(St[d], 1); }
            for (int s = 1; s <= 132; ++s) {
                const int cb = (s + 1) & 1;
                LAS bf16_t* Qc = (LAS bf16_t*)(F.lds + O_Q + cb * IMG); LAS bf16_t* Kc = (LAS bf16_t*)(F.lds + O_K + cb * IMG);
                LAS bf16_t* QKc = (LAS bf16_t*)(F.lds + O_QK + cb * QKB);
                LAS float* Tc = (LAS float*)(F.lds + O_TAB + cb * TABB);
                const int cc = s - 1;
                const bool isctx = cc < 4; const int c = isctx ? cc : cc - 4; const int L = isctx ? CTXL : SEQ;
                const int t0 = dir ? (L - 1 - 64 * c) : 64 * c; const int ts = dir ? -1 : 1;
                bf16x8 Vd[2][2], qa[8]; f32x16 Oq[2], A1;
                SCAN_BAR();
                {
                int l1 = F.lane; asm volatile("" : "+v"(l1));
                const int n32 = l1 & 31, hh = l1 >> 5, n16 = l1 & 15, grp = (l1 >> 4) & 1;
                const int e = 32 * wave + n32;
                const LAS bf16_t* utr = UT + e * PU + 4 * hh;
                const LAS bf16_t* wtr = WT + (4 * hh + (n16 >> 2)) * PT + 16 * grp + 4 * (n16 & 3);
                const LAS bf16_t* qkr = QKc + n32 * PU + 4 * hh;
                const LAS float* kdp = Tc + 192 + 4 * hh;
                bf16x8 wfa[8], wfb[8]; bf16x4 ur[2][4];
#pragma unroll
                for (int k = 0; k < 8; ++k) wfa[k] = cat8(trd(wtr + (16 * k) * PT), trd(wtr + (16 * k + 8) * PT));
#pragma unroll
                for (int mt = 0; mt < 2; ++mt)
#pragma unroll
                    for (int q = 0; q < 4; ++q) ur[mt][q] = ld8(utr + 32 * mt + 8 * q);
                SCHED();
                f32x16 zero16;
#pragma unroll
                for (int i = 0; i < 16; ++i) zero16[i] = 0.f;
                f32x16 P0 = zero16, P1 = zero16, vn0, vn1;
#pragma unroll
                for (int k = 0; k < 8; ++k) {
                    P0 = mfmaL(wfa[k], Sb[k >> 1][k & 1], P0);
                    wfb[k] = cat8(trd(wtr + (16 * k) * PT + 32), trd(wtr + (16 * k + 8) * PT + 32));
                    { const bf16x4 uv = ur[k >> 2][k & 3];
#pragma unroll
                      for (int r = 0; r < 4; ++r) { if (k < 4) vn0[4 * (k & 3) + r] = bf2f((bf16_t)uv[r]); else vn1[4 * (k & 3) + r] = bf2f((bf16_t)uv[r]); } }
                    SCHED();
                }
                bf16x8 Vb[2][2], a00[2], a10[2], a11[2]; f32x4 kd0[4], kd1[4];
#pragma unroll
                for (int k = 0; k < 8; ++k) {
                    P1 = mfmaL(wfb[k], Sb[k >> 1][k & 1], P1);
                    if (k == 0) {
#pragma unroll
                        for (int q = 0; q < 4; ++q) kd0[q] = *(const LAS f32x4*)(kdp + 8 * q);
                    }
                    if (k == 1) {
#pragma unroll
                        for (int s2 = 0; s2 < 2; ++s2) a00[s2] = cat8(ld8(qkr + 16 * s2), ld8(qkr + 16 * s2 + 8));
                    }
                    if (k >= 2 && k < 6) {
#pragma unroll
                        for (int r = 0; r < 4; ++r) vn0[4 * (k - 2) + r] = vn0[4 * (k - 2) + r] - P0[4 * (k - 2) + r];
                    }
                    if (k == 5) {
#pragma unroll
                        for (int s2 = 0; s2 < 2; ++s2) a10[s2] = cat8(ld8(qkr + 32 * PU + 16 * s2), ld8(qkr + 32 * PU + 16 * s2 + 8));
                    }
                    if (k == 6) { Vb[0][0] = packL(vn0, 0); Vb[0][1] = packL(vn0, 1); }
                    if (k == 7) {
#pragma unroll
                        for (int q = 0; q < 4; ++q)
#pragma unroll
                            for (int r = 0; r < 4; ++r) vn0[4 * q + r] = vn0[4 * q + r] * kd0[q][r];
                    }
                    SCHED();
                }
                Oq[0] = mfmaL(a00[0], Vb[0][0], zero16);
                Vd[0][0] = packL(vn0, 0); Vd[0][1] = packL(vn0, 1);
#pragma unroll
                for (int q = 0; q < 4; ++q) kd1[q] = *(const LAS f32x4*)(kdp + 32 + 8 * q);
#pragma unroll
                for (int s2 = 0; s2 < 2; ++s2) a11[s2] = cat8(ld8(qkr + 32 * PU + 32 + 16 * s2), ld8(qkr + 32 * PU + 32 + 16 * s2 + 8));
                SCHED();
                Oq[0] = mfmaL(a00[1], Vb[0][1], Oq[0]);
#pragma unroll
                for (int i = 0; i < 8; ++i) vn1[i] = vn1[i] - P1[i];
                SCHED();
                Oq[1] = mfmaL(a10[0], Vb[0][0], zero16);
#pragma unroll
                for (int i = 8; i < 16; ++i) vn1[i] = vn1[i] - P1[i];
                SCHED();
                Oq[1] = mfmaL(a10[1], Vb[0][1], Oq[1]);
                Vb[1][0] = packL(vn1, 0); Vb[1][1] = packL(vn1, 1);
                SCHED();
                Oq[1] = mfmaL(a11[0], Vb[1][0], Oq[1]);
#pragma unroll
                for (int q = 0; q < 4; ++q)
#pragma unroll
                    for (int r = 0; r < 4; ++r) vn1[4 * q + r] = vn1[4 * q + r] * kd1[q][r];
                SCHED();
                Oq[1] = mfmaL(a11[1], Vb[1][1], Oq[1]);
                Vd[1][0] = packL(vn1, 0); Vd[1][1] = packL(vn1, 1);

                    const LAS bf16_t* qsr0 = Qc + n32 * PQ + 4 * hh;
#pragma unroll
                    for (int k = 0; k < 8; ++k) qa[k] = cat8(ld8(qsr0 + 16 * k), ld8(qsr0 + 16 * k + 8));
                }
                SCHED();
                {
                    int l2 = F.lane; asm volatile("" : "+v"(l2));
                    const int n32 = l2 & 31, hh = l2 >> 5;
                    const LAS bf16_t* qsr = Qc + n32 * PQ + 4 * hh + 32 * PQ;
                    const LAS float* egp = Tc + 128 + 4 * hh;
                    bf16x8 qb[8]; f32x4 eg0[4];
                    f32x16 zero16;
#pragma unroll
                    for (int i = 0; i < 16; ++i) zero16[i] = 0.f;
                    f32x16 A0 = zero16; A1 = zero16;
#pragma unroll
                    for (int k = 0; k < 8; ++k) {
                        A0 = mfmaL(qa[k], Sb[k >> 1][k & 1], A0);
                        qb[k] = cat8(ld8(qsr + 16 * k), ld8(qsr + 16 * k + 8));
                        if (k == 0) {
#pragma unroll
                            for (int q = 0; q < 4; ++q) eg0[q] = *(const LAS f32x4*)(egp + 8 * q);
                        }
                        SCHED();
                    }
#pragma unroll
                    for (int k = 0; k < 8; ++k) {
                        A1 = mfmaL(qb[k], Sb[k >> 1][k & 1], A1);
                        if (k >= 2 && k < 6) {
#pragma unroll
                            for (int r = 0; r < 4; ++r) Oq[0][4 * (k - 2) + r] = A0[4 * (k - 2) + r] * eg0[k - 2][r] + Oq[0][4 * (k - 2) + r];
                        }
                        SCHED();
                    }
                }
                SCHED();
                {
                    int l3 = F.lane; asm volatile("" : "+v"(l3));
                    const int n32 = l3 & 31, hh = l3 >> 5, n16 = l3 & 15, grp = (l3 >> 4) & 1;
                    const int e = 32 * wave + n32;
                    const LAS bf16_t* ktr = Kc + (4 * hh + (n16 >> 2)) * PQ + 16 * grp + 4 * (n16 & 3);
                    const LAS float* egp = Tc + 128 + 32 + 4 * hh;
                    bf16x8 ka[8], kb2[8]; f32x4 eg1[4];
#pragma unroll
                    for (int j = 0; j < 8; ++j) ka[j] = cat8(trd(ktr + (16 * (j & 3)) * PQ + 32 * (j >> 2)), trd(ktr + (16 * (j & 3) + 8) * PQ + 32 * (j >> 2)));
#pragma unroll
                    for (int q = 0; q < 4; ++q) eg1[q] = *(const LAS f32x4*)(egp + 8 * q);
                    const float egl = Tc[256];
                    SCHED();
#pragma unroll
                    for (int q = 0; q < 4; ++q)
#pragma unroll
                        for (int r = 0; r < 4; ++r) Oq[1][4 * q + r] = A1[4 * q + r] * eg1[q][r] + Oq[1][4 * q + r];
                    St[0] = St[0] * egl; St[1] = St[1] * egl;
                    SCHED();
#pragma unroll
                    for (int j = 0; j < 8; ++j) {
                        if (j < 4) St[0] = mfmaL(ka[j], Vd[(j & 3) >> 1][j & 1], St[0]); else St[1] = mfmaL(ka[j], Vd[(j & 3) >> 1][j & 1], St[1]);
                        kb2[j] = cat8(trd(ktr + (16 * (j & 3)) * PQ + 32 * (2 + (j >> 2))), trd(ktr + (16 * (j & 3) + 8) * PQ + 32 * (2 + (j >> 2))));
#pragma unroll
                        for (int r = 0; r < 4; ++r) { if (j < 4) St[2][4 * (j & 3) + r] = St[2][4 * (j & 3) + r] * egl; else St[3][4 * (j & 3) + r] = St[3][4 * (j & 3) + r] * egl; }
                        SCHED();
                    }
#pragma unroll
                    for (int j = 0; j < 8; ++j) {
                        if (j < 4) St[2] = mfmaL(kb2[j], Vd[(j & 3) >> 1][j & 1], St[2]); else St[3] = mfmaL(kb2[j], Vd[(j & 3) >> 1][j & 1], St[3]);
                        SCHED();
                    }
                }
                SCAN_BAR();
                {
                    int l4 = F.lane; asm volatile("" : "+v"(l4));
                    const int n32 = l4 & 31, hh = l4 >> 5;
                    LAS bf16_t* Os = (LAS bf16_t*)(F.lds + O_OS);
                    if (!isctx) {
                        LAS bf16_t* osw = Os + (4 * hh) * POS + 32 * wave + n32;
#pragma unroll
                        for (int mt = 0; mt < 2; ++mt)
#pragma unroll
                            for (int q = 0; q < 4; ++q)
#pragma unroll
                                for (int r = 0; r < 4; ++r) osw[(32 * mt + 8 * q + r) * POS] = f2bf(Oq[mt][4 * q + r]);
                    }
#pragma unroll
                    for (int d = 0; d < 4; ++d) { Sb[d][0] = packL(St[d], 0); Sb[d][1] = packL(St[d], 1); }
                    if (!isctx) {
                        asm volatile("s_waitcnt lgkmcnt(0)" ::: "memory");
                        bf16_t* ob = dir ? OBp : OFp;
#pragma unroll
                        for (int q = 0; q < 4; ++q) { const int id = l4 + 64 * q; const int i = id >> 2, c4 = id & 3; const int t = t0 + ts * i;
                            const u32x4 v = *(const LAS u32x4*)(Os + i * POS + 32 * wave + 8 * c4);
                            *(u32x4*)(ob + (size_t)(b * SEQ + t) * D + h * HD + 64 * vh + 32 * wave + 8 * c4) = v; }
                    }
                }
            }
            SCAN_BAR();
            __builtin_amdgcn_s_setprio(0);
        } else {
            const int ptid = tidv - 256;
            u32x4 pf[10]; float pfa = 0.f, pfb = 0.f;
            const unsigned voff = (unsigned)((dir ? (15 - (ptid >> 4)) : (ptid >> 4)) * (3 * D * 2) + (ptid & 15) * 16);
            const int lst = (ptid >> 4) * PQ + 8 * (ptid & 15);
#define SCAN_PREFETCH(cc_, q0_, q1_, gates_) do { const int cc__ = (cc_); const bool ic_ = cc__ < 4; const int c_ = ic_ ? cc__ : cc__ - 4; const int L_ = ic_ ? CTXL : SEQ; const int rb_ = ic_ ? (T + b * CTXL) : b * SEQ; \
            const int t0_ = dir ? (L_ - 1 - 64 * c_) : 64 * c_; const int ts_ = dir ? -1 : 1; \
            const char* ub_ = (const char*)QKV + ((long)(rb_ + t0_) * (3 * D * 2) + h * (HD * 2) - (dir ? 15 * (3 * D * 2) : 0)); \
            _Pragma("unroll") for (int q_ = q0_; q_ < q1_; ++q_) { if (q_ < 8) pf[q_] = *(const u32x4*)(ub_ + ((long)(q_ >> 2) * (D * 2) + (long)ts_ * 16 * (q_ & 3) * (3 * D * 2)) + voff); \
                else pf[q_] = *(const u32x4*)((const char*)QKV + ((long)(rb_ + t0_ + ts_ * ((ptid >> 3) + 32 * (q_ - 8))) * (3 * D * 2) + 2 * (D * 2) + h * (HD * 2) + vh * 128 + (ptid & 7) * 16)); } \
            if (gates_ && wave == 4) { const size_t row_ = (size_t)(rb_ + t0_ + ts_ * F.lane); pfa = GB[row_ * 32 + 16 + dir * 8 + h]; pfb = GB[row_ * 32 + dir * 8 + h]; } } while (0)
            const int rt = wave - 4;
#define SCAN_STAGE_QK(cc_) do { const int bq_ = (cc_) & 1; LAS bf16_t* Qn_ = (LAS bf16_t*)(F.lds + O_Q + bq_ * IMG); LAS bf16_t* Kn_ = (LAS bf16_t*)(F.lds + O_K + bq_ * IMG); LAS float* Tn_ = (LAS float*)(F.lds + O_TAB + bq_ * TABB); \
            int lane_ = F.lane; asm volatile("" : "+v"(lane_)); \
            if (wave == 4) { const float gc_ = pfa; const float gl_ = __uint_as_float(__builtin_amdgcn_readlane(__float_as_uint(gc_), 63)); \
                Tn_[lane_] = gc_; Tn_[64 + lane_] = pfb; Tn_[128 + lane_] = __expf(gc_); Tn_[192 + lane_] = __expf(gl_ - gc_); if (lane_ == 0) Tn_[256] = __expf(gl_); } \
            _Pragma("unroll") for (int q_ = 0; q_ < 8; ++q_) { LAS bf16_t* dst_ = ((q_ >> 2) == 0 ? Qn_ : Kn_) + lst + 16 * (q_ & 3) * PQ; *(LAS u32x4*)dst_ = pf[q_]; } } while (0)
            SCAN_PREFETCH(0, 0, 10, true);
            SCAN_STAGE_QK(0);
            SCAN_PREFETCH(1, 0, 8, true);
            SCAN_BAR();
            for (int s = 0; s <= 132; ++s) {
                const int pb = s & 1;
                LAS bf16_t* Qp = (LAS bf16_t*)(F.lds + O_Q + pb * IMG); LAS bf16_t* Kp = (LAS bf16_t*)(F.lds + O_K + pb * IMG);
                LAS bf16_t* QKp = (LAS bf16_t*)(F.lds + O_QK + pb * QKB); LAS float* Tp = (LAS float*)(F.lds + O_TAB + pb * TABB);
                const bool act = s < 132;
                if (act) {
                    if (rt < 2) scan_b1<true, true>(F, rt, Kp, Qp, Tp, QKp, NLF, DTF); else scan_b1<true, false>(F, rt, Kp, Qp, Tp, QKp, NLF, DTF);
#pragma unroll
                    for (int q = 8; q < 10; ++q) *(LAS u32x4*)(Vs + ((ptid >> 3) + 32 * (q - 8)) * PV + 8 * (ptid & 7)) = pf[q];
                    if (s + 1 < 132) SCAN_PREFETCH(s + 1, 8, 10, false);
                }
                SCAN_BAR();
                if (act) {
                    scan_b3<2, 4>(F, rt, Vs, Kp, UT, WT, NLF, DTF);
                    if (s + 1 < 132) { SCAN_STAGE_QK(s + 1); if (s + 2 < 132) SCAN_PREFETCH(s + 2, 0, 8, true); }
                }
                SCAN_BAR();
            }
#undef SCAN_STAGE_QK
#undef SCAN_PREFETCH
        }
        __syncthreads();
    }
#undef SCAN_BAR
#undef SCHED
}

constexpr int LDS_BYTES = 163840;
constexpr int LDS_XB = LDS_BYTES - 16;
static_assert(scan::LDS_END <= LDS_XB && pg8::STAGE_BYTES + 2048 + 256 <= LDS_XB && 38 * 1024 * 4 + 128 <= LDS_XB, "LDS map");

__device__ __forceinline__ void moe_gemms(const Frame& F, const int l, const bool do1, const bool do2, const XcdBarrier& bar, const bool barrier_between) {
    const int* ESTART = (const int*)(F.ws + WS_META) + 256 * 32;
    LAS int* est = (LAS int*)(F.lds + pg8::TOK_OFF + 2048);
    if (do1) {
        __syncthreads();
        if (F.tid < 33) est[F.tid] = ESTART[F.tid];
        __syncthreads();
        pg8::MoeOrder S{est, F.G, F.bid, 4};
        EpiSwiglu E{(unsigned char*)(F.ws + WS_H)};
        pg8::gemm_phase<EpiSwiglu, pg8::MoeOrder, true, 1>(F.lds, (const bf16_t*)(F.ws + WS_A1), (const bf16_t*)((const unsigned char*)(F.ws + WS_W13) + (size_t)l * NE * 1024 * 1024), D, S, E, (const int*)(F.ws + WS_ROWTOK));
    }
    if (barrier_between) xcd_barrier(bar);
    if (do2) {
        __syncthreads();
        if (F.tid < 33) est[F.tid] = ESTART[F.tid];
        __syncthreads();
        pg8::MoeOrder S{est, F.G, F.bid, 4};
        EpiStoreFp8 E{(unsigned char*)(F.ws + WS_YB), D, YB_SCALE / (H_SCALE * W2_SCALE)};
        pg8::gemm_phase<EpiStoreFp8, pg8::MoeOrder, false, 1>(F.lds, (const bf16_t*)(F.ws + WS_H), (const bf16_t*)((const unsigned char*)(F.ws + WS_W2) + (size_t)l * NE * 1024 * 512), DE, S, E, nullptr);
    }
}

__global__ void __launch_bounds__(NTHREADS, 2) hybrid_fwd(Args args) {
    extern __shared__ __attribute__((aligned(16))) unsigned char lds_raw[];
    Frame F;
    F.lds = (LAS unsigned char*)lds_raw; F.tid = threadIdx.x; F.lane = F.tid & 63; F.wave = __builtin_amdgcn_readfirstlane(F.tid >> 6); F.G = gridDim.x; F.bid = blockIdx.x;
    F.out = args.out; F.ws = args.ws;
    const int lo = args.ph_lo, hi = args.ph_hi;
    unsigned* barw = (unsigned*)(F.ws + WS_CTL) + args.li * XCD_BAR_WORDS;
    XcdBarrier bar; bar.bar = barw; bar.x = 0; bar.st = (volatile LAS unsigned*)(F.lds + LDS_XB);
    if (hi - lo > 1) {
        if (F.tid == 0) { bar.st[0] = 0u; bar.st[1] = 0u; }
        __syncthreads();
        bar = xcd_barrier_post(barw, (volatile LAS unsigned*)(F.lds + LDS_XB));
    }
#ifndef PH_MASK
#define PH_MASK 0xfffff
#endif
#define IN(k) ((((PH_MASK) >> (k)) & 1) && lo <= (k) && (k) < hi)
#define SEAM(k) do { if (IN(k) && IN((k) + 1)) xcd_barrier(bar); } while (0)
    if (IN(0)) p0_prologue(args, F);
    SEAM(0);
    if (IN(1)) p_modulate0(args, F);
    SEAM(1);
    if (IN(2)) {
        pg8::StaticOrder S; S.init(MROWS, NPROJ_PAD, F.G, F.bid);
        EpiInProj E{(bf16_t*)(F.ws + WS_QKVP), (bf16_t*)(F.ws + WS_Z), (float*)(F.ws + WS_GB), (bf16_t*)(F.ws + WS_HALO)};
        pg8::gemm_phase<EpiInProj, pg8::StaticOrder, false>(F.lds, (const bf16_t*)(F.ws + WS_A1), (const bf16_t*)(F.ws + WS_WINA), D, S, E, nullptr);
    }
    SEAM(2);
    if (IN(3)) p_qkvprep(args, F);
    SEAM(3);
    if (IN(4)) {
        p_scan(args, F); __syncthreads();
        if (args.li != 1) p_transposes(args, F, F.bid + F.G * 133, F.G);
    }
    SEAM(4);
    if (IN(5)) p_finish(args, F);
    SEAM(5);
    if (IN(6)) {
        pg8::StaticOrder S; S.init(T, D, F.G, F.bid);
        EpiResid<false> E{args.in[0], (bf16_t*)(F.ws + WS_X), (const float*)(F.ws + WS_MOD) + 2 * 1024};
        pg8::gemm_phase<EpiResid<false>, pg8::StaticOrder, false>(F.lds, (const bf16_t*)(F.ws + WS_A1), (const bf16_t*)(F.ws + WS_WOUTA), D, S, E, nullptr);
    }
    SEAM(6);
    if (IN(7)) p_ffn_route(args, F, 0);
    SEAM(7);
    if (IN(8)) p_slots(args, F);
    SEAM(8);
    if (IN(9) || IN(10)) moe_gemms(F, 0, IN(9), IN(10), bar, IN(9) && IN(10));
    SEAM(10);
    if (IN(11)) p_combine<false>(args, F, 0);
    SEAM(11);
    if (IN(12)) {
        pg8::StaticOrder S; S.init(T, 3 * D, F.G, F.bid);
        EpiInB E{(bf16_t*)(F.ws + WS_GATEB), (bf16_t*)(F.ws + WS_U)};
        pg8::gemm_phase<EpiInB, pg8::StaticOrder, false>(F.lds, (const bf16_t*)(F.ws + WS_A1), (const bf16_t*)(F.ws + WS_WINB), D, S, E, nullptr);
    }
    SEAM(12);
    if (IN(13)) p_convgrid(args, F);
    SEAM(13);
    if (IN(14)) {
        pg8::StaticOrder S; S.init(T, D, F.G, F.bid);
        EpiResid<true> E{(const void*)(F.ws + WS_X), (bf16_t*)(F.ws + WS_X), (const float*)(F.ws + WS_MOD) + (size_t)9 * 6144 + 2 * 1024};
        pg8::gemm_phase<EpiResid<true>, pg8::StaticOrder, false>(F.lds, (const bf16_t*)(F.ws + WS_YY), (const bf16_t*)(F.ws + WS_WOUTB), D, S, E, nullptr);
    }
    SEAM(14);
    if (IN(15)) p_ffn_route(args, F, 1);
    SEAM(15);
    if (IN(16)) p_slots(args, F);
    SEAM(16);
    if (IN(17) || IN(18)) moe_gemms(F, 1, IN(17), IN(18), bar, IN(17) && IN(18));
    SEAM(18);
    if (IN(19)) p_combine<true>(args, F, 1);
#undef IN
#undef SEAM
}

extern "C" void kernel_launch(void* const* d_in, const int* in_sizes, int n_in, void* d_out, int out_size, void* d_ws, size_t ws_size, hipStream_t stream) {
    static int grid = 0;
    if (grid == 0) {
        if (n_in != 23 || out_size != T * D || ws_size < WS_END) { fprintf(stderr, "kernel_launch: unexpected problem shape (n_in %d, out %d, ws %zu < %zu)\n", n_in, out_size, ws_size, (size_t)WS_END); grid = -1; return; }
        int dev = 0, cus = 0, per_cu = 0;
        if (hipGetDevice(&dev) != hipSuccess || hipDeviceGetAttribute(&cus, hipDeviceAttributeMultiprocessorCount, dev) != hipSuccess) { grid = -1; return; }
        if (hipFuncSetAttribute((const void*)hybrid_fwd, hipFuncAttributeMaxDynamicSharedMemorySize, LDS_BYTES) != hipSuccess) { fprintf(stderr, "kernel_launch: hipFuncSetAttribute failed\n"); grid = -1; return; }
        if (hipOccupancyMaxActiveBlocksPerMultiprocessor(&per_cu, (const void*)hybrid_fwd, NTHREADS, LDS_BYTES) != hipSuccess || per_cu < 1) { fprintf(stderr, "kernel_launch: occupancy query says %d\n", per_cu); }
        (void)hipGetLastError();
        if (cus < NB * NH * 4) { fprintf(stderr, "kernel_launch: %d CUs, the scan phase needs %d co-resident workgroups\n", cus, NB * NH * 4); grid = -1; return; }
        grid = cus;
    }
    if (grid < 0) return;
    (void)hipMemsetAsync((char*)d_ws + WS_CTL, 0, CTL_BYTES, stream);
    Args a{};
    for (int i = 0; i < 23; ++i) a.in[i] = (const float*)d_in[i];
    a.out = (float*)d_out; a.ws = (unsigned char*)d_ws;
#if defined(PROBE_LO)
    a.ph_lo = 0; a.ph_hi = PROBE_HI; a.li = 0; hipLaunchKernelGGL(hybrid_fwd, dim3(grid), dim3(NTHREADS), LDS_BYTES, stream, a);
    a.ph_lo = PROBE_LO; a.ph_hi = PROBE_HI; a.li = 1; hipLaunchKernelGGL(hybrid_fwd, dim3(grid), dim3(NTHREADS), LDS_BYTES, stream, a);
    a.ph_lo = PROBE_HI; a.ph_hi = N_PHASES; a.li = 2; hipLaunchKernelGGL(hybrid_fwd, dim3(grid), dim3(NTHREADS), LDS_BYTES, stream, a);
#elif MK_ONE_LAUNCH
    a.ph_lo = 0; a.ph_hi = N_PHASES;
    hipLaunchKernelGGL(hybrid_fwd, dim3(grid), dim3(NTHREADS), LDS_BYTES, stream, a);
#else
    for (int p = 0; p < N_PHASES; ++p) { a.ph_lo = p; a.ph_hi = p + 1; hipLaunchKernelGGL(hybrid_fwd, dim3(grid), dim3(NTHREADS), LDS_BYTES, stream, a); }
#endif
}
```

```cpp
#include <hip/hip_runtime.h>
#include <cstdio>
#include <cstdint>

#define LAS __attribute__((address_space(3)))
typedef unsigned short bf16_t;
typedef short bf16x8 __attribute__((ext_vector_type(8)));
typedef short bf16x4 __attribute__((ext_vector_type(4)));
typedef float f32x4 __attribute__((ext_vector_type(4)));
typedef float f32x2 __attribute__((ext_vector_type(2)));
typedef unsigned u32x4 __attribute__((ext_vector_type(4)));
typedef unsigned u32x2 __attribute__((ext_vector_type(2)));
typedef __bf16 bf16v2 __attribute__((ext_vector_type(2)));
typedef int v8i32 __attribute__((ext_vector_type(8)));
typedef int v4i32 __attribute__((ext_vector_type(4)));

#ifndef MK_ONE_LAUNCH
#define MK_ONE_LAUNCH 1
#endif

constexpr int D = 1024, NB = 8, SEQ = 8192, T = NB * SEQ, CTXL = 256, TCTX = NB * CTXL, MROWS = T + TCTX;
constexpr int NH = 8, HD = 128, NE = 32, DE = 512;
constexpr int NPROJ = 4128, NPROJ_PAD = 4352;
constexpr int SLOT_MAX = 2 * T + NE * 256;
constexpr float EPS = 1e-6f;
constexpr int NTHREADS = 512;
constexpr int N_PHASES = 20;

constexpr size_t MiB = 1u << 20;
constexpr size_t WS_CTL = 0;
constexpr size_t CTL_BYTES = 64 * 1024;
constexpr size_t WS_MOD = 1 * MiB;
constexpr size_t WS_META = 2 * MiB;
constexpr size_t WS_WINA = 3 * MiB;
constexpr size_t WS_WOUTA = 12 * MiB;
constexpr size_t WS_WINB = 14 * MiB;
constexpr size_t WS_WOUTB = 20 * MiB;
constexpr size_t WS_W13 = 22 * MiB;
constexpr size_t WS_W2 = 150 * MiB;
constexpr size_t WS_A1 = 214 * MiB;
constexpr size_t WS_BIG = 346 * MiB;
constexpr size_t WS_QKVP = WS_BIG;
constexpr size_t WS_Z = WS_BIG + 396 * MiB;
constexpr size_t WS_GB = WS_BIG + 528 * MiB;
constexpr size_t WS_H = WS_BIG;
constexpr size_t WS_YB = WS_BIG + 136 * MiB;
constexpr size_t WS_REID = WS_BIG + 408 * MiB;
constexpr size_t WS_RWT = WS_REID + 1 * MiB;
constexpr size_t WS_RRANK = WS_REID + 2 * MiB;
constexpr size_t WS_POS = WS_REID + 3 * MiB;
constexpr size_t WS_ROWTOK = WS_REID + 4 * MiB;
constexpr size_t WS_GATEB = WS_BIG;
constexpr size_t WS_U = WS_BIG + 128 * MiB;
constexpr size_t WS_YY = WS_BIG + 256 * MiB;
constexpr size_t WS_HALO = WS_BIG + 540 * MiB;
constexpr size_t WS_X = WS_BIG + 544 * MiB;
constexpr size_t WS_END = WS_BIG + 672 * MiB;

__device__ __forceinline__ float bf2f(unsigned short v) { return __uint_as_float(((unsigned)v) << 16); }
__device__ __forceinline__ float bflo(unsigned v) { return __uint_as_float(v << 16); }
__device__ __forceinline__ float bfhi(unsigned v) { return __uint_as_float(v & 0xffff0000u); }
__device__ __forceinline__ unsigned pk_bf16(float a, float b) { f32x2 v = {a, b}; bf16v2 r = __builtin_convertvector(v, bf16v2); return __builtin_bit_cast(unsigned, r); }
__device__ __forceinline__ bf16_t f2bf(float a) { return (bf16_t)(pk_bf16(a, 0.f) & 0xffffu); }
__device__ __forceinline__ unsigned pk_fp8x4(float a, float b, float c, float d) {
    a = __builtin_amdgcn_fmed3f(a, -440.f, 440.f); b = __builtin_amdgcn_fmed3f(b, -440.f, 440.f); c = __builtin_amdgcn_fmed3f(c, -440.f, 440.f); d = __builtin_amdgcn_fmed3f(d, -440.f, 440.f);
    int p = 0; p = __builtin_amdgcn_cvt_pk_fp8_f32(a, b, p, false); p = __builtin_amdgcn_cvt_pk_fp8_f32(c, d, p, true); return (unsigned)p; }
constexpr float W13_SCALE = 64.f, W2_SCALE = 32.f, H_SCALE = 4.f, YB_SCALE = 16.f;
__device__ __forceinline__ float silu_f(float x) { return x * __builtin_amdgcn_rcpf(1.0f + __expf(-x)); }
__device__ __forceinline__ float row_sum16(float v) {
    v += __builtin_bit_cast(float, __builtin_amdgcn_update_dpp(0, __builtin_bit_cast(int, v), 0x128, 0xf, 0xf, false));
    v += __builtin_bit_cast(float, __builtin_amdgcn_update_dpp(0, __builtin_bit_cast(int, v), 0x124, 0xf, 0xf, false));
    v += __builtin_bit_cast(float, __builtin_amdgcn_update_dpp(0, __builtin_bit_cast(int, v), 0x122, 0xf, 0xf, false));
    v += __builtin_bit_cast(float, __builtin_amdgcn_update_dpp(0, __builtin_bit_cast(int, v), 0x121, 0xf, 0xf, false));
    return v;
}
__device__ __forceinline__ float wave_sum(float v) { v = row_sum16(v); v += __shfl_xor(v, 16); v += __shfl_xor(v, 32); return v; }
__device__ __forceinline__ bf16x8 pack8(const f32x4 a, const f32x4 b) {
    u32x4 p; p.x = pk_bf16(a[0], a[1]); p.y = pk_bf16(a[2], a[3]); p.z = pk_bf16(b[0], b[1]); p.w = pk_bf16(b[2], b[3]);
    return __builtin_bit_cast(bf16x8, p);
}
__device__ __forceinline__ bf16x4 pack4(const f32x4 a) { u32x2 p; p.x = pk_bf16(a[0], a[1]); p.y = pk_bf16(a[2], a[3]); return __builtin_bit_cast(bf16x4, p); }
__device__ __forceinline__ bf16x8 cat8(const bf16x4 a, const bf16x4 b) { return __builtin_shufflevector(a, b, 0, 1, 2, 3, 4, 5, 6, 7); }

#define XB_TMO      128
#define XB_XCNT(j)  (256  + 64 * (j))
#define XB_XSUB(j)  (1280 + 64 * (j))
#define XB_XGEN(j)  (2304 + 64 * (j))
#define XB_TOP      3328
#define XB_TOPGEN   3392
#define XCD_BAR_WORDS 3456
#define XB_SPIN_CAP (1u << 18)

__device__ __forceinline__ unsigned xb_ld(unsigned* p)              { return __hip_atomic_load(p, __ATOMIC_RELAXED, __HIP_MEMORY_SCOPE_AGENT); }
__device__ __forceinline__ unsigned xb_add(unsigned* p, unsigned v) { return __hip_atomic_fetch_add(p, v, __ATOMIC_RELAXED, __HIP_MEMORY_SCOPE_AGENT); }
__device__ __forceinline__ unsigned xb_xcc_id() { return (unsigned)__builtin_amdgcn_s_getreg((3 << 11) | 20) & 0xFu; }
#define XB_SPIN(cond, bar) do { unsigned _sp = 0; while (cond) { __builtin_amdgcn_s_sleep(1); \
    if ((++_sp & 255u) == 0u) { if (xb_ld(&(bar)[XB_TMO])) break; if (_sp > XB_SPIN_CAP) { atomicAdd(&(bar)[XB_TMO], 1u); break; } } } } while (0)

struct XcdBarrier { unsigned* bar; unsigned x; volatile LAS unsigned* st; };

__device__ __forceinline__ XcdBarrier xcd_barrier_post(unsigned* bar, volatile LAS unsigned* st) {
    XcdBarrier b; b.bar = bar; b.x = xb_xcc_id(); b.st = st;
    if (threadIdx.x == 0) (void)xb_add(&bar[XB_XCNT(b.x)], 1u);
    return b;
}
__device__ __forceinline__ void xcd_barrier_complete(unsigned* bar, unsigned x, unsigned& nloc, unsigned& nx) {
    const unsigned G = gridDim.x * gridDim.y * gridDim.z;
    unsigned sum, cnt, mine, sp = 0u;
    for (;;) {
        sum = 0u; cnt = 0u; mine = 0u;
#pragma unroll
        for (unsigned j = 0; j < 16; ++j) { const unsigned c = xb_ld(&bar[XB_XCNT(j)]); sum += c; cnt += (c > 0u) ? 1u : 0u; mine = (j == x) ? c : mine; }
        if (sum == G) break;
        __builtin_amdgcn_s_sleep(1);
        if ((++sp & 255u) == 0u) { if (xb_ld(&bar[XB_TMO])) break; if (sp > XB_SPIN_CAP) { atomicAdd(&bar[XB_TMO], 1u); break; } }
    }
    nloc = mine > 0u ? mine : 1u; nx = cnt > 0u ? cnt : 1u;
}
__device__ __forceinline__ void xcd_barrier(const XcdBarrier& b) {
    asm volatile("s_waitcnt vmcnt(0)" ::: "memory");
    __syncthreads();
    if (threadIdx.x == 0) {
        unsigned* bar = b.bar;
        __builtin_amdgcn_s_waitcnt(0);
        unsigned nloc = b.st[0], nx = b.st[1];
        if (nloc == 0u) { xcd_barrier_complete(bar, b.x, nloc, nx); b.st[0] = nloc; b.st[1] = nx; }
        const unsigned old = xb_add(&bar[XB_XSUB(b.x)], 1u);
        const unsigned gen = old / nloc;
        if (old + 1u == (gen + 1u) * nloc) {
            __builtin_amdgcn_fence(__ATOMIC_RELEASE, "agent");
            asm volatile("s_waitcnt vmcnt(0)" ::: "memory");
            const unsigned og = xb_add(&bar[XB_TOP], 1u);
            const unsigned tg = og / nx;
            if (og + 1u == (tg + 1u) * nx) xb_add(&bar[XB_TOPGEN], 1u);
            else XB_SPIN(xb_ld(&bar[XB_TOPGEN]) == tg, bar);
            __builtin_amdgcn_fence(__ATOMIC_ACQUIRE, "agent");
            xb_add(&bar[XB_XGEN(b.x)], 1u);
            asm volatile("s_waitcnt vmcnt(0)" ::: "memory");
        } else {
            XB_SPIN(xb_ld(&bar[XB_XGEN(b.x)]) == gen, bar);
            __builtin_amdgcn_fence(__ATOMIC_ACQUIRE, "agent");
            asm volatile("s_waitcnt vmcnt(0)" ::: "memory");
        }
    }
    __syncthreads();
}

namespace pg8 {
constexpr int BM = 256, BK = 64, HALF = 128, HTB = HALF * BK * 2, STAGE_BYTES = 8 * HTB, NXCD = 8, WGM = 8;
constexpr int TOK_OFF = STAGE_BYTES;
__host__ __device__ __forceinline__ int lds_byte(int r, int c) { const int st = (r >> 4) * 2 + (c >> 5), rr = r & 15, cc = c & 31, ob = rr * 64 + cc * 2; return st * 1024 + (ob ^ (((ob >> 9) & 1) << 5)); }
__host__ __device__ __forceinline__ void stage_rc(int b, int& R, int& C) { const int st = b / 1024, sb = b % 1024, swz = sb ^ (((sb >> 9) & 1) << 5); R = (st >> 1) * 16 + swz / 64; C = (st & 1) * 32 + (swz % 64) / 2; }
__host__ __device__ __forceinline__ int perm32(int rho) { const int n = rho >> 4, i = rho & 15; return 8 * (i >> 2) + 4 * n + (i & 3); }

struct Unit { int pm, pn, brow; };

struct StaticOrder {
    int nM, nN, nwg, G, c;
    __device__ void init(int M, int N, int G_, int c_) { nM = M / BM; nN = N / BM; nwg = nM * nN; G = G_; c = c_; }
    __device__ bool next(int i, Unit& u) const {
        const long L = (long)i * G + c; if (L >= nwg) return false;
        int wgid = (int)L; { const int q = nwg / NXCD, r = nwg % NXCD, xcd = wgid % NXCD, off = wgid / NXCD; wgid = (xcd < r ? xcd * (q + 1) : r * (q + 1) + (xcd - r) * q) + off; }
        const int nig = WGM * nN, gid = wgid / nig, fm = gid * WGM, gsz = (nM - fm) < WGM ? (nM - fm) : WGM;
        u.pm = fm + ((wgid % nig) % gsz); u.pn = (wgid % nig) / gsz; u.brow = u.pn; return true;
    }
};
struct MoeOrder {
    const LAS int* est; int G, c, lw;
    __device__ bool next(int i, Unit& u) const {
        const int U = i * G + c; const int NT = est[NE]; if (U >= NT * 4) return false;
        const int rt = U >> 2; int e = 0;
#pragma unroll
        for (int s = 16; s >= 1; s >>= 1) { if (est[e + s] <= rt) e += s; }
        u.pm = rt; u.pn = U & 3; u.brow = e * lw + (U & 3); return true;
    }
};

template <class Epi, class Sched, bool GATHER, int ESZ = 2>
__device__ __forceinline__ void gemm_phase(LAS unsigned char* lds, const bf16_t* Ag, const bf16_t* Btg, const int K, const Sched& S, const Epi& E, const int* rowtok) {
    const int tid = threadIdx.x, wid = __builtin_amdgcn_readfirstlane(tid >> 6), lane = tid & 63, wr = wid >> 2, wc = wid & 3, fr = lane & 15, fq = lane >> 4;
    const int rowb = K * ESZ;
    const int nt = rowb / 128;
    unsigned voffB[2], vc[2][2], vn[2][2]; int gR[2], gC[2];
    const size_t kstep = (size_t)(BK * 2);
    const size_t hstep = (size_t)HALF * rowb;
    const size_t tstep = 2 * hstep;
#pragma unroll
    for (int i = 0; i < 2; ++i) { int R, C; stage_rc(tid * 16 + i * 8192, R, C); const int Rb = Epi::PERM ? ((R & ~31) + perm32(R & 31)) : R;
        gR[i] = R; gC[i] = C; voffB[i] = (unsigned)(Rb * rowb + C * 2);
        vc[0][i] = (unsigned)(R * rowb + C * 2); vc[1][i] = vc[0][i] + (unsigned)hstep; vn[0][i] = vc[0][i]; vn[1][i] = vc[1][i]; }
    const unsigned ldsw = (unsigned)wid * 1024u;
    const int aoff = lds_byte(wr * 64 + fr, fq * 8), boff = lds_byte(wc * 32 + fr, fq * 8);
    LAS int* toks = (LAS int*)(lds + TOK_OFF);
#define PG8_SA(b, h) (((b) * 2 + (h)) * HTB)
#define PG8_SB(b, h) ((4 + (b) * 2 + (h)) * HTB)
#define PG8_STAGE(bufoff, gbase, v0, v1) do { \
        __builtin_amdgcn_global_load_lds((const unsigned*)((const char*)(gbase) + (v0)), (LAS unsigned*)(lds + (bufoff) + ldsw), 16, 0, 0); \
        __builtin_amdgcn_global_load_lds((const unsigned*)((const char*)(gbase) + (v1)), (LAS unsigned*)(lds + (bufoff) + ldsw + 8192), 16, 0, 0); } while (0)
#define PG8_STAGEB(bufoff, gbase) PG8_STAGE(bufoff, gbase, voffB[0], voffB[1])
#define PG8_LDA(dst, b, h) do { _Pragma("unroll") for (int m = 0; m < 4; ++m) _Pragma("unroll") for (int k = 0; k < 2; ++k) dst[m][k] = *(const LAS bf16x8*)(lds + PG8_SA(b, h) + aoff + m * 2048 + k * 1024); } while (0)
#define PG8_LDB(dst, b, h) do { _Pragma("unroll") for (int n = 0; n < 2; ++n) _Pragma("unroll") for (int k = 0; k < 2; ++k) dst[n][k] = *(const LAS bf16x8*)(lds + PG8_SB(b, h) + boff + n * 2048 + k * 1024); } while (0)
#define PG8_MMA(ai, bj, At, Bt) do { __builtin_amdgcn_s_setprio(1); if constexpr (ESZ == 2) { _Pragma("unroll") for (int m = 0; m < 4; ++m) _Pragma("unroll") for (int n = 0; n < 2; ++n) _Pragma("unroll") for (int k = 0; k < 2; ++k) \
        acc[ai][bj][m][n] = __builtin_amdgcn_mfma_f32_16x16x32_bf16(Bt[n][k], At[m][k], acc[ai][bj][m][n], 0, 0, 0); } else { \
        _Pragma("unroll") for (int m = 0; m < 4; ++m) _Pragma("unroll") for (int n = 0; n < 2; ++n) { \
            const v8i32 bb_ = __builtin_shufflevector(__builtin_bit_cast(v4i32, Bt[n][0]), __builtin_bit_cast(v4i32, Bt[n][1]), 0, 1, 2, 3, 4, 5, 6, 7); \
            const v8i32 aa_ = __builtin_shufflevector(__builtin_bit_cast(v4i32, At[m][0]), __builtin_bit_cast(v4i32, At[m][1]), 0, 1, 2, 3, 4, 5, 6, 7); \
            asm volatile("v_mfma_scale_f32_16x16x128_f8f6f4 %0, %1, %2, %0, %3, %3 op_sel_hi:[0,0,0]" : "+v"(acc[ai][bj][m][n]) : "v"(bb_), "v"(aa_), "v"(one_scale)); } } \
        __builtin_amdgcn_s_setprio(0); } while (0)
#define PG8_WAIT_V(n) asm volatile("s_waitcnt vmcnt(" #n ")" ::: "memory")
#define PG8_WAIT_L(n) asm volatile("s_waitcnt lgkmcnt(" #n ")" ::: "memory")
#define PG8_BAR __builtin_amdgcn_s_barrier()
#define PG8_SCHED __builtin_amdgcn_sched_barrier(0)
    const int one_scale = 0x7f7f7f7f;
    Unit cur, nxt; int ui = 0;
    if (!S.next(0, cur)) return;
    f32x4 acc[2][2][4][2];
#pragma unroll
    for (int a = 0; a < 2; ++a)
#pragma unroll
        for (int b = 0; b < 2; ++b)
#pragma unroll
            for (int m = 0; m < 4; ++m)
#pragma unroll
                for (int n = 0; n < 2; ++n) acc[a][b][m][n] = (f32x4){0.f, 0.f, 0.f, 0.f};
    bf16x8 At[4][2], B0[2][2], B1[2][2];
    const char* cA = GATHER ? (const char*)Ag : (const char*)Ag + (size_t)cur.pm * tstep;
    const char* cB = (const char*)Btg + (size_t)cur.brow * tstep;
    if constexpr (GATHER) {
        if (tid < 256) toks[tid] = rowtok[cur.pm * 256 + tid];
        __syncthreads();
#pragma unroll
        for (int h = 0; h < 2; ++h)
#pragma unroll
            for (int i = 0; i < 2; ++i) { vc[h][i] = (unsigned)toks[h * 128 + gR[i]] * (unsigned)rowb + (unsigned)(gC[i] * 2); vn[h][i] = vc[h][i]; }
    }
    PG8_STAGEB(PG8_SB(0, 0), cB); PG8_STAGEB(PG8_SB(0, 1), cB + hstep); PG8_STAGE(PG8_SA(0, 0), cA, vc[0][0], vc[0][1]); PG8_STAGE(PG8_SA(0, 1), cA, vc[1][0], vc[1][1]);
    if (wr == 1) PG8_BAR;
    PG8_WAIT_V(2); PG8_BAR;
    PG8_STAGEB(PG8_SB(1, 0), cB + kstep); PG8_STAGE(PG8_SA(1, 0), cA + kstep, vc[0][0], vc[0][1]); PG8_STAGEB(PG8_SB(1, 1), cB + hstep + kstep);
    PG8_WAIT_V(6); PG8_BAR;
    for (;;) {
        const bool has_next = S.next(ui + 1, nxt);
        const char* nA = GATHER ? (const char*)Ag : (has_next ? (const char*)Ag + (size_t)nxt.pm * tstep : cA);
        const char* nB = has_next ? (const char*)Btg + (size_t)nxt.brow * tstep : cB;
        if constexpr (GATHER) {
            if (has_next && wid < 4) __builtin_amdgcn_global_load_lds((const unsigned*)(rowtok + nxt.pm * 256 + wid * 64 + lane), (LAS unsigned*)(toks + ((ui + 1) & 1) * 256 + wid * 64), 4, 0, 0);
        }
#pragma unroll 1
        for (int t = 0; t < nt; t += 2) {
            const bool last = (t == nt - 2);
            const char* a1 = cA + (size_t)(t + 1) * kstep;
            const char* a2 = last ? nA : cA + (size_t)(t + 2) * kstep; const char* b2 = last ? nB : cB + (size_t)(t + 2) * kstep;
            const char* a3 = a2 + kstep; const char* b3 = b2 + kstep;
            if constexpr (GATHER) {
                if (last && has_next) {
                    const LAS int* tk = toks + ((ui + 1) & 1) * 256;
#pragma unroll
                    for (int h = 0; h < 2; ++h)
#pragma unroll
                        for (int i = 0; i < 2; ++i) vn[h][i] = (unsigned)tk[h * 128 + gR[i]] * (unsigned)rowb + (unsigned)(gC[i] * 2);
                }
            }
            const unsigned s00 = last ? vn[0][0] : vc[0][0], s01 = last ? vn[0][1] : vc[0][1], s10 = last ? vn[1][0] : vc[1][0], s11 = last ? vn[1][1] : vc[1][1];
            PG8_LDB(B0, 0, 0); PG8_LDB(B1, 0, 1); PG8_SCHED; PG8_LDA(At, 0, 0); PG8_STAGE(PG8_SA(1, 1), a1, vc[1][0], vc[1][1]);
            PG8_WAIT_V(8); PG8_WAIT_L(0); PG8_BAR; PG8_MMA(0, 0, At, B0); PG8_MMA(0, 1, At, B1); PG8_BAR; PG8_SCHED;
            PG8_LDA(At, 0, 1); PG8_STAGEB(PG8_SB(0, 0), b2); PG8_STAGEB(PG8_SB(0, 1), b2 + hstep); PG8_STAGE(PG8_SA(0, 0), a2, s00, s01);
            PG8_WAIT_V(8); PG8_WAIT_L(0); PG8_BAR; PG8_MMA(1, 0, At, B0); PG8_MMA(1, 1, At, B1); PG8_BAR; PG8_SCHED;
            PG8_LDB(B0, 1, 0); PG8_LDB(B1, 1, 1); PG8_SCHED; PG8_LDA(At, 1, 0); PG8_STAGE(PG8_SA(0, 1), a2, s10, s11);
            PG8_WAIT_V(8); PG8_WAIT_L(0); PG8_BAR; PG8_MMA(0, 0, At, B0); PG8_MMA(0, 1, At, B1); PG8_BAR; PG8_SCHED;
            PG8_LDA(At, 1, 1); PG8_STAGEB(PG8_SB(1, 0), b3); PG8_STAGEB(PG8_SB(1, 1), b3 + hstep); PG8_STAGE(PG8_SA(1, 0), a3, s00, s01);
            PG8_WAIT_V(8); PG8_WAIT_L(0); PG8_BAR; PG8_MMA(1, 0, At, B0); PG8_MMA(1, 1, At, B1); PG8_BAR; PG8_SCHED;
        }
        if (wr == 0) PG8_BAR;
        if constexpr (ESZ == 1) asm volatile("s_nop 15\n\ts_nop 15\n\ts_nop 15" ::: "memory");
        E(acc, cur, wr, wc, fr, fq);
        if (!has_next) break;
#pragma unroll
        for (int a = 0; a < 2; ++a)
#pragma unroll
            for (int b = 0; b < 2; ++b)
#pragma unroll
                for (int m = 0; m < 4; ++m)
#pragma unroll
                    for (int n = 0; n < 2; ++n) acc[a][b][m][n] = (f32x4){0.f, 0.f, 0.f, 0.f};
        cur = nxt; cA = nA; cB = nB; ++ui;
#pragma unroll
        for (int h = 0; h < 2; ++h)
#pragma unroll
            for (int i = 0; i < 2; ++i) vc[h][i] = vn[h][i];
        if (wr == 1) PG8_BAR;
    }
    PG8_WAIT_V(0);
    PG8_BAR;
#undef PG8_SA
#undef PG8_SB
#undef PG8_STAGE
#undef PG8_STAGEB
#undef PG8_LDA
#undef PG8_LDB
#undef PG8_MMA
#undef PG8_WAIT_V
#undef PG8_WAIT_L
#undef PG8_BAR
#undef PG8_SCHED
}
}

struct EpiInProj {
    static constexpr bool PERM = true;
    bf16_t* qkvp; bf16_t* z; float* gb; bf16_t* halo;
    __device__ __forceinline__ void operator()(const f32x4 (&acc)[2][2][4][2], const pg8::Unit& u, int wr, int wc, int fr, int fq) const {
        const int row0 = u.pm * 256 + wr * 64 + fr;
        if (u.pn < 16) {
            bf16_t* base; int ld, colt;
            if (u.pn < 12) { base = qkvp; ld = 3 * D; colt = u.pn * 256; } else { base = z; ld = D; colt = (u.pn - 12) * 256; }
            const int col0 = colt + wc * 32 + 8 * fq;
#pragma unroll
            for (int ai = 0; ai < 2; ++ai)
#pragma unroll
                for (int m = 0; m < 4; ++m) { bf16_t* rowp = base + (size_t)(row0 + ai * 128 + m * 16) * ld + col0;
#pragma unroll
                    for (int bj = 0; bj < 2; ++bj) { const f32x4 v0 = acc[ai][bj][m][0], v1 = acc[ai][bj][m][1];
                        u32x4 w; w.x = pk_bf16(v0[0], v0[1]); w.y = pk_bf16(v0[2], v0[3]); w.z = pk_bf16(v1[0], v1[1]); w.w = pk_bf16(v1[2], v1[3]);
                        __builtin_nontemporal_store(w, (u32x4*)(rowp + bj * 128));
                        if (u.pn < 12 && fr == (ai ? 15 : 0) && wr == ai && m == (ai ? 3 : 0)) *(u32x4*)(halo + ((size_t)u.pm * 2 + ai) * (3 * D) + col0 + bj * 128) = w; } }
        } else if (wc == 0) {
            const int lc0 = 8 * fq;
#pragma unroll
            for (int ai = 0; ai < 2; ++ai)
#pragma unroll
                for (int m = 0; m < 4; ++m) { float* rowp = gb + (size_t)(row0 + ai * 128 + m * 16) * 32 + lc0;
                    *(f32x4*)(rowp) = acc[ai][0][m][0]; *(f32x4*)(rowp + 4) = acc[ai][0][m][1]; }
        }
    }
};
template <bool BASE_BF16> struct EpiResid {
    static constexpr bool PERM = true;
    const void* base; bf16_t* out; const float* gate;
    __device__ __forceinline__ void operator()(const f32x4 (&acc)[2][2][4][2], const pg8::Unit& u, int wr, int wc, int fr, int fq) const {
        const int row0 = u.pm * 256 + wr * 64 + fr, col0 = u.pn * 256 + wc * 32 + 8 * fq;
        const float* gp = gate + (size_t)((u.pm * 256) / SEQ) * 6144 + col0;
        f32x4 gv[2][2];
#pragma unroll
        for (int bj = 0; bj < 2; ++bj)
#pragma unroll
            for (int n = 0; n < 2; ++n) gv[bj][n] = *(const f32x4*)(gp + bj * 128 + n * 4);
        f32x4 bA[2][2][2], bB[2][2][2];
#define ER_LOAD(dst, q_) do { const int ai_ = (q_) >> 1, mp_ = (q_) & 1; \
        _Pragma("unroll") for (int mm = 0; mm < 2; ++mm) { const size_t off = (size_t)(row0 + ai_ * 128 + (2 * mp_ + mm) * 16) * D + col0; \
            _Pragma("unroll") for (int bj = 0; bj < 2; ++bj) { \
                if constexpr (BASE_BF16) { const u32x4 t = *(const u32x4*)((const bf16_t*)base + off + bj * 128); dst[mm][bj][0] = __builtin_bit_cast(f32x4, t); } \
                else { dst[mm][bj][0] = *(const f32x4*)((const float*)base + off + bj * 128); dst[mm][bj][1] = *(const f32x4*)((const float*)base + off + bj * 128 + 4); } } } } while (0)
#define ER_STORE(src, q_) do { const int ai_ = (q_) >> 1, mp_ = (q_) & 1; \
        _Pragma("unroll") for (int mm = 0; mm < 2; ++mm) { const int m = 2 * mp_ + mm; const size_t off = (size_t)(row0 + ai_ * 128 + m * 16) * D + col0; \
            _Pragma("unroll") for (int bj = 0; bj < 2; ++bj) { f32x4 b0, b1; \
                if constexpr (BASE_BF16) { const u32x4 t = __builtin_bit_cast(u32x4, src[mm][bj][0]); b0 = (f32x4){bflo(t.x), bfhi(t.x), bflo(t.y), bfhi(t.y)}; b1 = (f32x4){bflo(t.z), bfhi(t.z), bflo(t.w), bfhi(t.w)}; } \
                else { b0 = src[mm][bj][0]; b1 = src[mm][bj][1]; } \
                const f32x4 v0 = b0 + gv[bj][0] * acc[ai_][bj][m][0], v1 = b1 + gv[bj][1] * acc[ai_][bj][m][1]; \
                u32x4 w; w.x = pk_bf16(v0[0], v0[1]); w.y = pk_bf16(v0[2], v0[3]); w.z = pk_bf16(v1[0], v1[1]); w.w = pk_bf16(v1[2], v1[3]); \
                *(u32x4*)(out + off + bj * 128) = w; } } } while (0)
        ER_LOAD(bA, 0);
        ER_LOAD(bB, 1);
        __builtin_amdgcn_sched_barrier(0);
        ER_STORE(bA, 0);
        __builtin_amdgcn_sched_barrier(0);
        ER_LOAD(bA, 2);
        __builtin_amdgcn_sched_barrier(0);
        ER_STORE(bB, 1);
        __builtin_amdgcn_sched_barrier(0);
        ER_LOAD(bB, 3);
        __builtin_amdgcn_sched_barrier(0);
        ER_STORE(bA, 2);
        __builtin_amdgcn_sched_barrier(0);
        ER_STORE(bB, 3);
#undef ER_LOAD
#undef ER_STORE
    }
};
struct EpiSwiglu {
    static constexpr bool PERM = true;
    unsigned char* Hb;
    __device__ __forceinline__ void operator()(const f32x4 (&acc)[2][2][4][2], const pg8::Unit& u, int wr, int wc, int fr, int fq) const {
        const int row0 = u.pm * 256 + wr * 64 + fr, col0 = u.pn * 128 + wc * 32 + 8 * fq;
        const float is = 1.0f / W13_SCALE;
#pragma unroll
        for (int ai = 0; ai < 2; ++ai)
#pragma unroll
            for (int m = 0; m < 4; ++m) { float o[8];
#pragma unroll
                for (int j = 0; j < 8; ++j) { const float a = acc[ai][0][m][j >> 2][j & 3], b = acc[ai][1][m][j >> 2][j & 3];
                    const float r = __builtin_amdgcn_rcpf(1.0f + __builtin_amdgcn_exp2f(a * (-is * 1.4426950408889634f))); o[j] = (a * b) * (r * (is * is * H_SCALE)); }
                u32x2 w; w.x = pk_fp8x4(o[0], o[1], o[2], o[3]); w.y = pk_fp8x4(o[4], o[5], o[6], o[7]);
                *(u32x2*)(Hb + (size_t)(row0 + ai * 128 + m * 16) * DE + col0) = w; }
    }
};
struct EpiStoreFp8 {
    static constexpr bool PERM = true;
    unsigned char* O; int ld; float sc;
    __device__ __forceinline__ void operator()(const f32x4 (&acc)[2][2][4][2], const pg8::Unit& u, int wr, int wc, int fr, int fq) const {
        const int row0 = u.pm * 256 + wr * 64 + fr, col0 = u.pn * 256 + wc * 32 + 8 * fq;
#pragma unroll
        for (int ai = 0; ai < 2; ++ai)
#pragma unroll
            for (int m = 0; m < 4; ++m) { unsigned char* rowp = O + (size_t)(row0 + ai * 128 + m * 16) * ld + col0;
#pragma unroll
                for (int bj = 0; bj < 2; ++bj) { const f32x4 v0 = acc[ai][bj][m][0] * sc, v1 = acc[ai][bj][m][1] * sc;
                    u32x2 w; w.x = pk_fp8x4(v0[0], v0[1], v0[2], v0[3]); w.y = pk_fp8x4(v1[0], v1[1], v1[2], v1[3]);
                    *(u32x2*)(rowp + bj * 128) = w; } }
    }
};
struct EpiInB {
    static constexpr bool PERM = true;
    bf16_t* gateb; bf16_t* ub;
    __device__ __forceinline__ void operator()(const f32x4 (&acc)[2][2][4][2], const pg8::Unit& u, int wr, int wc, int fr, int fq) const {
        const int row0 = u.pm * 256 + wr * 64 + fr;
        if (u.pn < 4) {
            const int col0 = u.pn * 256 + wc * 32 + 8 * fq;
#pragma unroll
            for (int ai = 0; ai < 2; ++ai)
#pragma unroll
                for (int m = 0; m < 4; ++m) { bf16_t* rowp = gateb + (size_t)(row0 + ai * 128 + m * 16) * D + col0;
#pragma unroll
                    for (int bj = 0; bj < 2; ++bj) { const f32x4 v0 = acc[ai][bj][m][0], v1 = acc[ai][bj][m][1];
                        u32x4 w; w.x = pk_bf16(v0[0], v0[1]); w.y = pk_bf16(v0[2], v0[3]); w.z = pk_bf16(v1[0], v1[1]); w.w = pk_bf16(v1[2], v1[3]);
                        *(u32x4*)(rowp + bj * 128) = w; } }
        } else {
            const int col0 = (u.pn - 4) * 128 + wc * 32 + 8 * fq;
#pragma unroll
            for (int ai = 0; ai < 2; ++ai)
#pragma unroll
                for (int m = 0; m < 4; ++m) { const f32x4 a0 = acc[ai][0][m][0], a1 = acc[ai][0][m][1], b0 = acc[ai][1][m][0], b1 = acc[ai][1][m][1];
                    u32x4 w; w.x = pk_bf16(a0[0] * b0[0], a0[1] * b0[1]); w.y = pk_bf16(a0[2] * b0[2], a0[3] * b0[3]); w.z = pk_bf16(a1[0] * b1[0], a1[1] * b1[1]); w.w = pk_bf16(a1[2] * b1[2], a1[3] * b1[3]);
                    *(u32x4*)(ub + (size_t)(row0 + ai * 128 + m * 16) * D + col0) = w; }
        }
    }
};

struct Args { const float* in[23]; float* out; unsigned char* ws; int ph_lo, ph_hi, li, pad; };

struct Frame {
    LAS unsigned char* lds; int tid, lane, wave, G, bid;
    float* out; unsigned char* ws;
};
#define FIN(k) (args.in[k])

__device__ __forceinline__ void transpose_tile(const Args& args, const Frame& F, const float* src, int lds_, int nvalid, bf16_t* dst, int ldd) {
    LAS float* tile = (LAS float*)F.lds;
    const int r = F.tid >> 4, c4 = (F.tid & 15) * 4;
#pragma unroll
    for (int p = 0; p < 2; ++p) {
        f32x4 v = (f32x4){0.f, 0.f, 0.f, 0.f};
        if (c4 < nvalid) v = *(const f32x4*)(src + (size_t)(r + 32 * p) * lds_ + c4);
#pragma unroll
        for (int j = 0; j < 4; ++j) tile[(r + 32 * p) * 65 + c4 + j] = v[j];
    }
    __syncthreads();
    const int n = F.tid >> 3, kk = (F.tid & 7) * 8;
    float o[8];
#pragma unroll
    for (int j = 0; j < 8; ++j) o[j] = tile[(kk + j) * 65 + n];
    u32x4 w; w.x = pk_bf16(o[0], o[1]); w.y = pk_bf16(o[2], o[3]); w.z = pk_bf16(o[4], o[5]); w.w = pk_bf16(o[6], o[7]);
    *(u32x4*)(dst + (size_t)n * ldd + kk) = w;
    __syncthreads();
}

__device__ __forceinline__ void transpose_tile_fp8(const Args& args, const Frame& F, const float* src, int lds_, unsigned char* dst, int ldd, float sc) {
    LAS float* tile = (LAS float*)F.lds;
    const int r = F.tid >> 4, c4 = (F.tid & 15) * 4;
#pragma unroll
    for (int p = 0; p < 2; ++p) {
        const f32x4 v = *(const f32x4*)(src + (size_t)(r + 32 * p) * lds_ + c4);
#pragma unroll
        for (int j = 0; j < 4; ++j) tile[(r + 32 * p) * 65 + c4 + j] = v[j] * sc;
    }
    __syncthreads();
    const int n = F.tid >> 3, kk = (F.tid & 7) * 8;
    float o[8];
#pragma unroll
    for (int j = 0; j < 8; ++j) o[j] = tile[(kk + j) * 65 + n];
    u32x2 w; w.x = pk_fp8x4(o[0], o[1], o[2], o[3]); w.y = pk_fp8x4(o[4], o[5], o[6], o[7]);
    *(u32x2*)(dst + (size_t)n * ldd + kk) = w;
    __syncthreads();
}
__device__ __forceinline__ void p0_prologue(const Args& args, const Frame& F) {
    const float* c = args.in[1]; const float* cctx = args.in[3]; const float* ada_w = args.in[4]; const float* ada_b = args.in[5];
    float* MOD = (float*)(F.ws + WS_MOD);
    {
        LAS float* sc = (LAS float*)F.lds;
        LAS float* red = (LAS float*)(F.lds + 9 * 1024 * 4);
        {   float cvv[18];
#pragma unroll
            for (int u = 0; u < 18; ++u) { const int i = F.tid + NTHREADS * u; cvv[u] = (i < 8 * 1024) ? c[i] : cctx[i - 8 * 1024]; }
#pragma unroll
            for (int u = 0; u < 18; ++u) sc[F.tid + NTHREADS * u] = silu_f(cvv[u]); }
        __syncthreads();
        const int cc = F.tid & 31, kg = F.tid >> 5;
        for (int q = F.bid; q < 384; q += F.G) {
            const int l = q / 192, n0 = (q % 192) * 32;
            const float* wp = ada_w + (size_t)l * 1024 * 6144 + n0 + cc;
            float a[9];
#pragma unroll
            for (int b = 0; b < 9; ++b) a[b] = 0.f;
            for (int j = 0; j < 64; ++j) { const int k = kg + 16 * j; const float wv = wp[(size_t)k * 6144];
#pragma unroll
                for (int b = 0; b < 9; ++b) a[b] += sc[b * 1024 + k] * wv; }
#pragma unroll
            for (int b = 0; b < 9; ++b) red[(kg * 9 + b) * 32 + cc] = a[b];
            __syncthreads();
            if (F.tid < 288) { const int b = F.tid >> 5; float s = ada_b[l * 6144 + n0 + cc];
#pragma unroll
                for (int g = 0; g < 16; ++g) s += red[(g * 9 + b) * 32 + cc];
                MOD[((size_t)l * 9 + b) * 6144 + n0 + cc] = s; }
            __syncthreads();
        }
    }
    {
        LAS float* tile = (LAS float*)F.lds;
        const int r = F.tid >> 4, c4 = (F.tid & 15) * 4;
        f32x4 pv[2], cv2[2];
#define P0_TLOAD(dst, q_) do { const int nt_ = (q_) >> 4, kt_ = (q_) & 15, n0_ = nt_ * 64; int nv_ = NPROJ - n0_; nv_ = nv_ < 0 ? 0 : (nv_ > 64 ? 64 : nv_); \
        const float* src_ = args.in[8] + (size_t)(kt_ * 64) * NPROJ + n0_; \
        _Pragma("unroll") for (int p = 0; p < 2; ++p) { dst[p] = (f32x4){0.f, 0.f, 0.f, 0.f}; if (c4 < nv_) dst[p] = *(const f32x4*)(src_ + (size_t)(r + 32 * p) * NPROJ + c4); } } while (0)
        if (F.bid < 1088) P0_TLOAD(pv, F.bid);
        for (int q = F.bid; q < 1088; q += F.G) {
            cv2[0] = pv[0]; cv2[1] = pv[1];
            if (q + F.G < 1088) P0_TLOAD(pv, q + F.G);
            const int ntile = q >> 4, kt = q & 15, n0 = ntile * 64;
            bf16_t* dst = (bf16_t*)(F.ws + WS_WINA) + (size_t)n0 * 1024 + kt * 64;
#pragma unroll
            for (int p = 0; p < 2; ++p)
#pragma unroll
                for (int j = 0; j < 4; ++j) tile[(r + 32 * p) * 65 + c4 + j] = cv2[p][j];
            __syncthreads();
            const int n = F.tid >> 3, kk = (F.tid & 7) * 8;
            float o[8];
#pragma unroll
            for (int j = 0; j < 8; ++j) o[j] = tile[(kk + j) * 65 + n];
            u32x4 w; w.x = pk_bf16(o[0], o[1]); w.y = pk_bf16(o[2], o[3]); w.z = pk_bf16(o[4], o[5]); w.w = pk_bf16(o[6], o[7]);
            *(u32x4*)(dst + (size_t)n * 1024 + kk) = w;
            __syncthreads();
        }
#undef P0_TLOAD
    }
}
__device__ __forceinline__ void p_transposes(const Args& args, const Frame& F, const int first, const int stride) {
    const int NSMALL = 1280, NMOE = 2 * NE * 384;
    for (int q = first; q < NSMALL + NMOE; q += stride) {
        if (q < 256) {
            const int ntile = q >> 4, kt = q & 15;
            transpose_tile(args, F, args.in[13] + (size_t)(kt * 64) * D + ntile * 64, D, 64, (bf16_t*)(F.ws + WS_WOUTA) + (size_t)(ntile * 64) * 1024 + kt * 64, 1024);
        } else if (q < 1024) {
            const int qq = q - 256, ntile = qq >> 4, kt = qq & 15, nd = ntile * 64, j = nd >> 8, w = nd & 255;
            const int ns = (j < 4) ? nd : ((w < 128) ? (1024 + 128 * (j - 4) + w) : (2048 + 128 * (j - 4) + (w - 128)));
            transpose_tile(args, F, args.in[14] + (size_t)(kt * 64) * 3072 + ns, 3072, 64, (bf16_t*)(F.ws + WS_WINB) + (size_t)nd * 1024 + kt * 64, 1024);
        } else if (q < 1280) {
            const int qq = q - 1024, ntile = qq >> 4, kt = qq & 15;
            transpose_tile(args, F, args.in[16] + (size_t)(kt * 64) * D + ntile * 64, D, 64, (bf16_t*)(F.ws + WS_WOUTB) + (size_t)(ntile * 64) * 1024 + kt * 64, 1024);
        } else {
            const int qq = q - NSMALL, le = qq / 384, r = qq % 384;
            if (r < 256) {
                const int ntile = r >> 4, kt = r & 15, nd = ntile * 64, j = nd >> 8, w = nd & 255;
                const float* src = (w < 128) ? args.in[19] : args.in[20]; const int ns = 128 * j + (w & 127);
                transpose_tile_fp8(args, F, src + (size_t)le * 1024 * 512 + (size_t)(kt * 64) * 512 + ns, 512, (unsigned char*)(F.ws + WS_W13) + ((size_t)le * 1024 + nd) * 1024 + kt * 64, 1024, W13_SCALE);
            } else {
                const int rr = r - 256, ntile = rr >> 3, kt = rr & 7;
                transpose_tile_fp8(args, F, args.in[21] + (size_t)le * 512 * 1024 + (size_t)(kt * 64) * 1024 + ntile * 64, 1024, (unsigned char*)(F.ws + WS_W2) + ((size_t)le * 1024 + ntile * 64) * 512 + kt * 64, 512, W2_SCALE);
            }
        }
    }
}

struct TTile { const float* src; int ld; unsigned char* dst; int ldd; int fp8; float sc; };
__device__ __forceinline__ TTile tt_decode(const Args& args, const Frame& F, const int q) {
    TTile t; t.fp8 = 0; t.sc = 1.f;
    if (q < 256) { const int ntile = q >> 4, kt = q & 15;
        t.src = args.in[13] + (size_t)(kt * 64) * D + ntile * 64; t.ld = D; t.dst = (unsigned char*)((bf16_t*)(F.ws + WS_WOUTA) + (size_t)(ntile * 64) * 1024 + kt * 64); t.ldd = 2048;
    } else if (q < 1024) { const int qq = q - 256, ntile = qq >> 4, kt = qq & 15, nd = ntile * 64, j = nd >> 8, w = nd & 255;
        const int ns = (j < 4) ? nd : ((w < 128) ? (1024 + 128 * (j - 4) + w) : (2048 + 128 * (j - 4) + (w - 128)));
        t.src = args.in[14] + (size_t)(kt * 64) * 3072 + ns; t.ld = 3072; t.dst = (unsigned char*)((bf16_t*)(F.ws + WS_WINB) + (size_t)nd * 1024 + kt * 64); t.ldd = 2048;
    } else if (q < 1280) { const int qq = q - 1024, ntile = qq >> 4, kt = qq & 15;
        t.src = args.in[16] + (size_t)(kt * 64) * D + ntile * 64; t.ld = D; t.dst = (unsigned char*)((bf16_t*)(F.ws + WS_WOUTB) + (size_t)(ntile * 64) * 1024 + kt * 64); t.ldd = 2048;
    } else { const int qq = q - 1280, le = qq / 384, r = qq % 384; t.fp8 = 1;
        if (r < 256) { const int ntile = r >> 4, kt = r & 15, nd = ntile * 64, j = nd >> 8, w = nd & 255;
            const float* src = (w < 128) ? args.in[19] : args.in[20]; const int ns = 128 * j + (w & 127);
            t.src = src + (size_t)le * 1024 * 512 + (size_t)(kt * 64) * 512 + ns; t.ld = 512; t.dst = (unsigned char*)(F.ws + WS_W13) + ((size_t)le * 1024 + nd) * 1024 + kt * 64; t.ldd = 1024; t.sc = W13_SCALE;
        } else { const int rr = r - 256, ntile = rr >> 3, kt = rr & 7;
            t.src = args.in[21] + (size_t)le * 512 * 1024 + (size_t)(kt * 64) * 1024 + ntile * 64; t.ld = 1024; t.dst = (unsigned char*)(F.ws + WS_W2) + ((size_t)le * 1024 + ntile * 64) * 512 + kt * 64; t.ldd = 512; t.sc = W2_SCALE; }
    }
    return t;
}
constexpr int TT_TILES = 1280 + 2 * NE * 384;

__device__ __forceinline__ void p_qkvprep(const Args& args, const Frame& F) {
    {
        float* GBw = (float*)(F.ws + WS_GB);
        for (int w = F.bid * NTHREADS + F.tid; w < (MROWS / 64) * 16; w += F.G * NTHREADS) {
            const int chunk = w >> 4, dh = w & 15; const bool bwd = dh >= 8;
            const float neg_a = -__expf(args.in[10][dh]), dtb = args.in[11][dh];
            float* p = GBw + (size_t)chunk * 64 * 32 + dh;
            float acc = 0.f;
            for (int k0 = 0; k0 < 64; k0 += 32) {
                float av[32], bv[32];
#pragma unroll
                for (int k = 0; k < 32; ++k) { const int t = bwd ? (63 - k0 - k) : (k0 + k); av[k] = p[t * 32 + 16]; bv[k] = p[t * 32]; }
#pragma unroll
                for (int k = 0; k < 32; ++k) { const int t = bwd ? (63 - k0 - k) : (k0 + k);
                    const float xx = av[k] + dtb; const float sp = xx > 15.f ? xx : __logf(1.0f + __expf(xx));
                    acc += neg_a * sp; p[t * 32 + 16] = acc; p[t * 32] = __builtin_amdgcn_rcpf(1.0f + __expf(-bv[k])); }
            }
        }
    }
    bf16_t* QKVP = (bf16_t*)(F.ws + WS_QKVP); const bf16_t* HALO = (const bf16_t*)(F.ws + WS_HALO); const float* conv_a = args.in[9];
    const int nwv = F.G * 8;
    for (int u = F.bid * 8 + F.wave; u < (MROWS / 256) * 6; u += nwv) {
        const int tile = u / 6, slab = u % 6; const int col = slab * 512 + 8 * F.lane; const int mm = col >> 10;
        const bool lat = tile < T / 256; const bool sstart = lat ? ((tile & 31) == 0) : true, send = lat ? ((tile & 31) == 31) : true;
        float w0[8], w1[8], w2[8];
#pragma unroll
        for (int j = 0; j < 8; ++j) { w0[j] = conv_a[col + j]; w1[j] = conv_a[3072 + col + j]; w2[j] = conv_a[6144 + col + j]; }
        bf16_t* base = QKVP + (size_t)tile * 256 * (3 * D) + col;
        const u32x4 zero4 = (u32x4){0u, 0u, 0u, 0u};
        u32x4 prev = sstart ? zero4 : *(const u32x4*)(HALO + ((size_t)(tile - 1) * 2 + 1) * (3 * D) + col);
        u32x4 cur = *(const u32x4*)(base);
        const u32x4 after = send ? zero4 : *(const u32x4*)(HALO + ((size_t)(tile + 1) * 2) * (3 * D) + col);
        for (int t0 = 0; t0 < 256; t0 += 8) {
            u32x4 nx[8];
#pragma unroll
            for (int k = 0; k < 8; ++k) { const int t = t0 + k + 1; nx[k] = (t < 256) ? *(const u32x4*)(base + (size_t)t * (3 * D)) : after; }
#pragma unroll
            for (int k = 0; k < 8; ++k) {
                float y[8];
#pragma unroll
                for (int j = 0; j < 4; ++j) {
                    y[2 * j] = silu_f(w0[2 * j] * bflo(prev[j]) + w1[2 * j] * bflo(cur[j]) + w2[2 * j] * bflo(nx[k][j]));
                    y[2 * j + 1] = silu_f(w0[2 * j + 1] * bfhi(prev[j]) + w1[2 * j + 1] * bfhi(cur[j]) + w2[2 * j + 1] * bfhi(nx[k][j])); }
                if (mm < 2) {
                    float ss = 0.f;
#pragma unroll
                    for (int j = 0; j < 8; ++j) ss += y[j] * y[j];
                    ss = row_sum16(ss);
                    const float sc = rsqrtf(ss + EPS) * (mm == 0 ? 0.08838834764831845f : 1.0f);
#pragma unroll
                    for (int j = 0; j < 8; ++j) y[j] *= sc;
                }
                u32x4 w; w.x = pk_bf16(y[0], y[1]); w.y = pk_bf16(y[2], y[3]); w.z = pk_bf16(y[4], y[5]); w.w = pk_bf16(y[6], y[7]);
                *(u32x4*)(base + (size_t)(t0 + k) * (3 * D)) = w;
                prev = cur; cur = nx[k];
            }
        }
    }
}

__device__ __forceinline__ void p_modulate0(const Args& args, const Frame& F) {
    const float* x = args.in[0]; const float* ctx = args.in[2]; const float* nrm = args.in[6];
    const float* MOD = (const float*)(F.ws + WS_MOD);
    bf16_t* Hh = (bf16_t*)(F.ws + WS_A1);
    const int nw = F.G * 8, gw = F.bid * 8 + F.wave, per = (MROWS + nw - 1) / nw;
    const int r0 = gw * per, r1 = (r0 + per) < MROWS ? (r0 + per) : MROWS;
    if (r0 >= r1) return;
    f32x4 gv[4];
#pragma unroll
    for (int j = 0; j < 4; ++j) gv[j] = *(const f32x4*)(nrm + 4 * F.lane + 256 * j);
    f32x4 v[4], vnx[4];
#define P1_LOAD(dst, r_) do { const int rr_ = (r_); const float* src_ = (rr_ < T) ? (x + (size_t)rr_ * D) : (ctx + (size_t)(rr_ - T) * D); \
        _Pragma("unroll") for (int j = 0; j < 4; ++j) dst[j] = *(const f32x4*)(src_ + 4 * F.lane + 256 * j); } while (0)
    P1_LOAD(v, r0);
    int cur_md = -1; f32x4 av[4], cv[4];
    for (int r = r0; r < r1; ++r) {
        if (r + 1 < r1) P1_LOAD(vnx, r + 1);
        const int mdi = (r < T) ? (r / SEQ) : 8;
        if (mdi != cur_md) { cur_md = mdi; const float* md = MOD + (size_t)mdi * 6144;
#pragma unroll
            for (int j = 0; j < 4; ++j) { const int c = 4 * F.lane + 256 * j; av[j] = gv[j] * (*(const f32x4*)(md + 1024 + c) + 1.0f); cv[j] = *(const f32x4*)(md + c); } }
        float ss = 0.f;
#pragma unroll
        for (int j = 0; j < 4; ++j) ss += v[j][0] * v[j][0] + v[j][1] * v[j][1] + v[j][2] * v[j][2] + v[j][3] * v[j][3];
        ss = wave_sum(ss);
        const float rs = rsqrtf(ss * (1.0f / D) + EPS);
#pragma unroll
        for (int j = 0; j < 4; ++j) { const int c = 4 * F.lane + 256 * j;
            const f32x4 o = v[j] * rs * av[j] + cv[j];
            u32x2 w; w.x = pk_bf16(o[0], o[1]); w.y = pk_bf16(o[2], o[3]); *(u32x2*)(Hh + (size_t)r * D + c) = w; }
#pragma unroll
        for (int j = 0; j < 4; ++j) v[j] = vnx[j];
    }
#undef P1_LOAD
}

__device__ __forceinline__ void p_finish(const Args& args, const Frame& F) {
    const bf16_t* OFp = (const bf16_t*)F.out; const bf16_t* OBp = OFp + (size_t)T * D; const bf16_t* Z = (const bf16_t*)(F.ws + WS_Z);
    const float* onorm = args.in[12]; bf16_t* Y = (bf16_t*)(F.ws + WS_A1);
    const int nw = F.G * 8, gw = F.bid * 8 + F.wave, per = (T + nw - 1) / nw;
    const int r0 = gw * per, r1 = (r0 + per) < T ? (r0 + per) : T;
    if (r0 >= r1) return;
    float on[16];
#pragma unroll
    for (int j = 0; j < 16; ++j) on[j] = onorm[(16 * F.lane + j) & 127];
    u32x4 c[6], n[6];
#define P5_LOAD(dst, r_) do { const size_t off_ = (size_t)(r_) * D + 16 * F.lane; dst[0] = *(const u32x4*)(OFp + off_); dst[1] = *(const u32x4*)(OFp + off_ + 8); \
        dst[2] = *(const u32x4*)(OBp + off_); dst[3] = *(const u32x4*)(OBp + off_ + 8); dst[4] = *(const u32x4*)(Z + off_); dst[5] = *(const u32x4*)(Z + off_ + 8); } while (0)
    P5_LOAD(c, r0);
    for (int r = r0; r < r1; ++r) {
        if (r + 1 < r1) P5_LOAD(n, r + 1);
        const size_t off = (size_t)r * D + 16 * F.lane;
        float o[16], zz[16]; float ss = 0.f;
#pragma unroll
        for (int j = 0; j < 4; ++j) {
            o[2 * j] = bflo(c[0][j]) + bflo(c[2][j]); o[2 * j + 1] = bfhi(c[0][j]) + bfhi(c[2][j]);
            o[8 + 2 * j] = bflo(c[1][j]) + bflo(c[3][j]); o[8 + 2 * j + 1] = bfhi(c[1][j]) + bfhi(c[3][j]);
            zz[2 * j] = bflo(c[4][j]); zz[2 * j + 1] = bfhi(c[4][j]); zz[8 + 2 * j] = bflo(c[5][j]); zz[8 + 2 * j + 1] = bfhi(c[5][j]); }
#pragma unroll
        for (int j = 0; j < 16; ++j) ss += o[j] * o[j];
        ss += __shfl_xor(ss, 1); ss += __shfl_xor(ss, 2); ss += __shfl_xor(ss, 4);
        const float rs = rsqrtf(ss * (1.0f / HD) + EPS);
        float y[16];
#pragma unroll
        for (int j = 0; j < 16; ++j) y[j] = o[j] * rs * on[j] * silu_f(zz[j]);
        u32x4 w0, w1; w0.x = pk_bf16(y[0], y[1]); w0.y = pk_bf16(y[2], y[3]); w0.z = pk_bf16(y[4], y[5]); w0.w = pk_bf16(y[6], y[7]);
        w1.x = pk_bf16(y[8], y[9]); w1.y = pk_bf16(y[10], y[11]); w1.z = pk_bf16(y[12], y[13]); w1.w = pk_bf16(y[14], y[15]);
        *(u32x4*)(Y + off) = w0; *(u32x4*)(Y + off + 8) = w1;
#pragma unroll
        for (int j = 0; j < 6; ++j) c[j] = n[j];
    }
#undef P5_LOAD
}

__device__ __forceinline__ void p_ffn_route(const Args& args, const Frame& F, const int l) {
    const bf16_t* X = (const bf16_t*)(F.ws + WS_X); const float* nrm = args.in[7] + l * D; const float* MOD = (const float*)(F.ws + WS_MOD) + (size_t)l * 9 * 6144;
    const float* rg = args.in[17] + (size_t)l * D * 4; const float* re = args.in[18] + (size_t)l * D * NE;
    unsigned char* Hf = (unsigned char*)(F.ws + WS_A1);
    int* REID = (int*)(F.ws + WS_REID); float* RWT = (float*)(F.ws + WS_RWT); int* RRANK = (int*)(F.ws + WS_RRANK); int* TCNT = (int*)(F.ws + WS_META);
    LAS float* RT = (LAS float*)F.lds;
    LAS float* AB = (LAS float*)(F.lds + 36 * 1024 * 4);
    LAS int* cntl = (LAS int*)(F.lds + 38 * 1024 * 4);
    {   f32x4 tg[2], te[16];
#pragma unroll
        for (int u = 0; u < 2; ++u) tg[u] = *(const f32x4*)(rg + 4 * (F.tid + NTHREADS * u));
#pragma unroll
        for (int u = 0; u < 16; ++u) te[u] = *(const f32x4*)(re + 4 * (F.tid + NTHREADS * u));
#pragma unroll
        for (int u = 0; u < 2; ++u) { const int k = F.tid + NTHREADS * u;
#pragma unroll
            for (int g = 0; g < 4; ++g) RT[g * 1024 + k] = tg[u][g]; }
#pragma unroll
        for (int u = 0; u < 16; ++u) { const int v4 = F.tid + NTHREADS * u, k = v4 >> 3, e0 = (v4 & 7) * 4;
#pragma unroll
            for (int j = 0; j < 4; ++j) RT[(4 + e0 + j) * 1024 + k] = te[u][j]; }
    }
    const int tq = F.lane >> 4, j4 = 4 * (F.lane & 15);
    for (int tile = F.bid; tile < T / 256; tile += F.G) {
        __syncthreads();
        const float* md = MOD + (size_t)((tile * 256) / SEQ) * 6144;
        for (int i = F.tid; i < 1024; i += NTHREADS) { AB[i] = nrm[i] * (md[4 * 1024 + i] + 1.0f); AB[1024 + i] = md[3 * 1024 + i]; }
        if (F.tid < 32) cntl[F.tid] = 0;
        __syncthreads();
        u32x2 xr[16];
        { const bf16_t* src0 = X + (size_t)(tile * 256 + F.wave * 32 + tq) * D + j4;
#pragma unroll
          for (int m = 0; m < 16; ++m) xr[m] = *(const u32x2*)(src0 + 64 * m); }
#pragma unroll 1
        for (int qd = 0; qd < 8; ++qd) {
            const int r = tile * 256 + F.wave * 32 + qd * 4 + tq;
            f32x4 v[16]; float ss = 0.f;
#pragma unroll
            for (int m = 0; m < 16; ++m) { const u32x2 t = xr[m]; v[m] = (f32x4){bflo(t.x), bfhi(t.x), bflo(t.y), bfhi(t.y)}; ss += v[m][0] * v[m][0] + v[m][1] * v[m][1] + v[m][2] * v[m][2] + v[m][3] * v[m][3]; }
            if (qd < 7) { const bf16_t* srcn = X + (size_t)(r + 4) * D + j4;
#pragma unroll
                for (int m = 0; m < 16; ++m) xr[m] = *(const u32x2*)(srcn + 64 * m); }
            ss = row_sum16(ss);
            const float rs = rsqrtf(ss * (1.0f / D) + EPS);
            unsigned char* hp = Hf + (size_t)r * D + j4;
#pragma unroll
            for (int m = 0; m < 16; ++m) { const f32x4 a = *(const LAS f32x4*)(AB + j4 + 64 * m), c = *(const LAS f32x4*)(AB + 1024 + j4 + 64 * m);
                v[m] = v[m] * rs * a + c;
                *(unsigned*)(hp + 64 * m) = pk_fp8x4(v[m][0], v[m][1], v[m][2], v[m][3]); }
            float lg[4];
#pragma unroll
            for (int g = 0; g < 4; ++g) { float s = 0.f; const LAS float* wp = RT + g * 1024 + j4;
#pragma unroll
                for (int m = 0; m < 16; ++m) { const f32x4 w = *(const LAS f32x4*)(wp + 64 * m); s += v[m][0] * w[0] + v[m][1] * w[1] + v[m][2] * w[2] + v[m][3] * w[3]; }
                lg[g] = row_sum16(s); }
            int gi = 0; float lm = lg[0];
#pragma unroll
            for (int g = 1; g < 4; ++g) if (lg[g] > lm) { lm = lg[g]; gi = g; }
            float den = 0.f;
#pragma unroll
            for (int g = 0; g < 4; ++g) den += __expf(lg[g] - lm);
            const float pg = 1.0f / den;
            float le[8];
            const LAS float* we = RT + (4 + gi * 8) * 1024 + j4;
#pragma unroll
            for (int e = 0; e < 8; ++e) { float s = 0.f;
#pragma unroll
                for (int m = 0; m < 16; ++m) { const f32x4 w = *(const LAS f32x4*)(we + e * 1024 + 64 * m); s += v[m][0] * w[0] + v[m][1] * w[1] + v[m][2] * w[2] + v[m][3] * w[3]; }
                le[e] = row_sum16(s); }
            int i1 = 0; float m1 = le[0];
#pragma unroll
            for (int e = 1; e < 8; ++e) if (le[e] > m1) { m1 = le[e]; i1 = e; }
            int i2 = -1; float m2 = -3.0e38f;
#pragma unroll
            for (int e = 0; e < 8; ++e) if (e != i1 && le[e] > m2) { m2 = le[e]; i2 = e; }
            const float ex = __expf(m2 - m1); const float w1 = pg / (1.0f + ex), w2 = pg * ex / (1.0f + ex);
            if ((F.lane & 15) == 0) {
                const int e1 = gi * 8 + i1, e2 = gi * 8 + i2;
                const int k1 = __hip_atomic_fetch_add(cntl + e1, 1, __ATOMIC_RELAXED, __HIP_MEMORY_SCOPE_WORKGROUP); const int k2 = __hip_atomic_fetch_add(cntl + e2, 1, __ATOMIC_RELAXED, __HIP_MEMORY_SCOPE_WORKGROUP);
                REID[2 * r] = e1; REID[2 * r + 1] = e2; RWT[2 * r] = w1; RWT[2 * r + 1] = w2; RRANK[2 * r] = k1; RRANK[2 * r + 1] = k2;
            }
        }
        __syncthreads();
        if (F.tid < 32) TCNT[tile * 32 + F.tid] = cntl[F.tid];
    }
}

__device__ __forceinline__ void p_slots(const Args& args, const Frame& F) {
    const int* TCNT = (const int*)(F.ws + WS_META); int* ESTART = (int*)(F.ws + WS_META) + 256 * 32;
    const int* REID = (const int*)(F.ws + WS_REID); const int* RRANK = (const int*)(F.ws + WS_RRANK); int* POS = (int*)(F.ws + WS_POS); int* ROWTOK = (int*)(F.ws + WS_ROWTOK);
    LAS int* tc = (LAS int*)F.lds;
    LAS int* part = tc + 256 * 32;
    LAS int* tot = part + 16 * 32;
    LAS int* sp = tot + 32;
    {   v4i32 tv[4];
#pragma unroll
        for (int u = 0; u < 4; ++u) tv[u] = *(const v4i32*)(TCNT + 4 * (F.tid + NTHREADS * u));
#pragma unroll
        for (int u = 0; u < 4; ++u) *(LAS v4i32*)(tc + 4 * (F.tid + NTHREADS * u)) = tv[u]; }
    __syncthreads();
    const int e = F.tid & 31, pt = F.tid >> 5;
    { int s = 0; for (int j = 0; j < 16; ++j) { const int v = tc[(pt * 16 + j) * 32 + e]; tc[(pt * 16 + j) * 32 + e] = s; s += v; } part[pt * 32 + e] = s; }
    __syncthreads();
    if (F.tid < 32) { int s = 0; for (int j = 0; j < 16; ++j) { const int v = part[j * 32 + e]; part[j * 32 + e] = s; s += v; } tot[e] = s; }
    __syncthreads();
    if (F.tid == 0) { int s = 0; for (int j = 0; j < 32; ++j) { sp[j] = s; s += (tot[j] + 255) & ~255; } sp[32] = s; }
    __syncthreads();
    if (F.bid == 0 && F.tid < 33) ESTART[F.tid] = sp[F.tid] >> 8;
    for (int tile = F.bid; tile < T / 256; tile += F.G) {
        const int p = tile * 512 + F.tid; const int ee = REID[p];
        const int slot = sp[ee] + part[(tile >> 4) * 32 + ee] + tc[tile * 32 + ee] + RRANK[p];
        POS[p] = slot; ROWTOK[slot] = p >> 1;
    }
    for (int ee = F.bid; ee < NE; ee += F.G) { const int a = sp[ee] + tot[ee], b = sp[ee + 1]; for (int s = a + F.tid; s < b; s += NTHREADS) ROWTOK[s] = 0; }
}

template <bool FINAL>
__device__ __forceinline__ void p_combine(const Args& args, const Frame& F, const int l) {
    bf16_t* X = (bf16_t*)(F.ws + WS_X); float* OUT = F.out; const unsigned char* YB = (const unsigned char*)(F.ws + WS_YB); const int* POS = (const int*)(F.ws + WS_POS); const float* RWT = (const float*)(F.ws + WS_RWT);
    const float* MODl = (const float*)(F.ws + WS_MOD) + (size_t)l * 9 * 6144;
    const float* MODn = (const float*)(F.ws + WS_MOD) + (size_t)(l + 1) * 9 * 6144;
    const float* nrm = FINAL ? args.in[22] : (args.in[6] + (l + 1) * D);
    bf16_t* Hh = (bf16_t*)(F.ws + WS_A1);
    const int nw = F.G * 8, gw = F.bid * 8 + F.wave, per = (T + nw - 1) / nw;
    const int r0 = gw * per, r1 = (r0 + per) < T ? (r0 + per) : T;
    if (r0 >= r1) return;
    f32x4 gv[4];
#pragma unroll
    for (int j = 0; j < 4; ++j) gv[j] = *(const f32x4*)(nrm + 4 * F.lane + 256 * j);
    u32x2 xc[4], xn[4]; unsigned yac[4], ybc[4], yan[4], ybn[4]; float w0c, w1c, w0n = 0.f, w1n = 0.f;
#define CB_LOAD(xd, yad, ybd, w0d, w1d, r_) do { const int rr_ = (r_); const int p0_ = POS[2 * rr_], p1_ = POS[2 * rr_ + 1]; w0d = RWT[2 * rr_] * (1.0f / YB_SCALE); w1d = RWT[2 * rr_ + 1] * (1.0f / YB_SCALE); \
        _Pragma("unroll") for (int j = 0; j < 4; ++j) { const int c_ = 4 * F.lane + 256 * j; xd[j] = *(const u32x2*)(X + (size_t)rr_ * D + c_); \
            yad[j] = *(const unsigned*)(YB + (size_t)p0_ * D + c_); ybd[j] = *(const unsigned*)(YB + (size_t)p1_ * D + c_); } } while (0)
    CB_LOAD(xc, yac, ybc, w0c, w1c, r0);
    int cur_b = -1; f32x4 gtv[4], av[4], cv[4];
    for (int r = r0; r < r1; ++r) {
        if (r + 1 < r1) CB_LOAD(xn, yan, ybn, w0n, w1n, r + 1);
        const int b = r / SEQ;
        if (b != cur_b) { cur_b = b; const float* gt = MODl + (size_t)b * 6144 + 5 * 1024; const float* md = MODn + (size_t)b * 6144;
#pragma unroll
            for (int j = 0; j < 4; ++j) { const int c = 4 * F.lane + 256 * j; gtv[j] = *(const f32x4*)(gt + c);
                if constexpr (!FINAL) { av[j] = gv[j] * (*(const f32x4*)(md + 1024 + c) + 1.0f); cv[j] = *(const f32x4*)(md + c); } } }
        bf16_t* xp = X + (size_t)r * D; float* op = OUT + (size_t)r * D;
        f32x4 v[4]; float ss = 0.f;
#pragma unroll
        for (int j = 0; j < 4; ++j) {
            f32x4 xv = (f32x4){bflo(xc[j].x), bfhi(xc[j].x), bflo(xc[j].y), bfhi(xc[j].y)};
            const f32x2 ya0 = __builtin_amdgcn_cvt_pk_f32_fp8((int)yac[j], false), ya1 = __builtin_amdgcn_cvt_pk_f32_fp8((int)yac[j], true), yb0 = __builtin_amdgcn_cvt_pk_f32_fp8((int)ybc[j], false), yb1 = __builtin_amdgcn_cvt_pk_f32_fp8((int)ybc[j], true);
            f32x4 m; m[0] = w0c * ya0[0] + w1c * yb0[0]; m[1] = w0c * ya0[1] + w1c * yb0[1]; m[2] = w0c * ya1[0] + w1c * yb1[0]; m[3] = w0c * ya1[1] + w1c * yb1[1];
            xv = xv + gtv[j] * m; v[j] = xv;
            ss += xv[0] * xv[0] + xv[1] * xv[1] + xv[2] * xv[2] + xv[3] * xv[3]; }
        ss = wave_sum(ss);
        const float rs = rsqrtf(ss * (1.0f / D) + EPS);
#pragma unroll
        for (int j = 0; j < 4; ++j) { const int c = 4 * F.lane + 256 * j;
            if constexpr (FINAL) { *(f32x4*)(op + c) = v[j] * rs * gv[j]; }
            else { u32x2 xw; xw.x = pk_bf16(v[j][0], v[j][1]); xw.y = pk_bf16(v[j][2], v[j][3]); *(u32x2*)(xp + c) = xw;
                const f32x4 o = v[j] * rs * av[j] + cv[j];
                u32x2 w; w.x = pk_bf16(o[0], o[1]); w.y = pk_bf16(o[2], o[3]); *(u32x2*)(Hh + (size_t)r * D + c) = w; } }
#pragma unroll
        for (int j = 0; j < 4; ++j) { xc[j] = xn[j]; yac[j] = yan[j]; ybc[j] = ybn[j]; }
        w0c = w0n; w1c = w1n;
    }
#undef CB_LOAD
}

__device__ __forceinline__ void p_convgrid(const Args& args, const Frame& F) {
    const bf16_t* GBp = (const bf16_t*)(F.ws + WS_GATEB); const bf16_t* U = (const bf16_t*)(F.ws + WS_U); bf16_t* YY = (bf16_t*)(F.ws + WS_YY);
    const float* cw = args.in[15];
    constexpr int RB = 8;
    for (int task = F.bid * 8 + F.wave; task < 2048; task += F.G * 8) {
        const bool vert = task >= 1024; const int tk = vert ? task - 1024 : task;
        const int bb = vert ? (tk >> 7) : (tk >> 7);
        const int t00 = vert ? ((tk & 63) + 64 * 64 * ((tk >> 6) & 1)) : 64 * (tk & 127);
        const int step = vert ? 64 : 1;
        const int ch = (vert ? 512 : 0) + 8 * F.lane;
        float w0[8], w1[8], w2[8];
#pragma unroll
        for (int j = 0; j < 8; ++j) { w0[j] = cw[ch + j]; w1[j] = cw[1024 + ch + j]; w2[j] = cw[2048 + ch + j]; }
        const bf16_t* up = U + ((size_t)bb * SEQ + t00) * D + ch; const bf16_t* gp = GBp + ((size_t)bb * SEQ + t00) * D + ch; bf16_t* yp = YY + ((size_t)bb * SEQ + t00) * D + ch;
        const size_t rs = (size_t)step * D;
        const u32x4 z = (u32x4){0u, 0u, 0u, 0u};
        const bool has_lo = vert && ((tk >> 6) & 1), has_hi = vert && !((tk >> 6) & 1);
        u32x4 prev = has_lo ? *(const u32x4*)(up - rs) : z;
        u32x4 cur = *(const u32x4*)up;
#pragma unroll 1
        for (int i0 = 0; i0 < 64; i0 += RB) {
            u32x4 xs[RB + 2], gs[RB];
            xs[0] = prev; xs[1] = cur;
#pragma unroll
            for (int k = 0; k < RB; ++k) {
                const int i = i0 + k + 1;
                xs[k + 2] = (i < 64) ? *(const u32x4*)(up + (size_t)i * rs) : (has_hi ? *(const u32x4*)(up + (size_t)64 * rs) : z);
                gs[k] = *(const u32x4*)(gp + (size_t)(i0 + k) * rs);
            }
#pragma unroll
            for (int k = 0; k < RB; ++k) {
                const u32x4 m = xs[k], c = xs[k + 1], q = xs[k + 2], g = gs[k];
                float y[8];
#pragma unroll
                for (int j = 0; j < 4; ++j) {
                    y[2 * j]     = bflo(g[j]) * (w0[2 * j] * bflo(m[j]) + w1[2 * j] * bflo(c[j]) + w2[2 * j] * bflo(q[j]));
                    y[2 * j + 1] = bfhi(g[j]) * (w0[2 * j + 1] * bfhi(m[j]) + w1[2 * j + 1] * bfhi(c[j]) + w2[2 * j + 1] * bfhi(q[j])); }
                u32x4 o; o.x = pk_bf16(y[0], y[1]); o.y = pk_bf16(y[2], y[3]); o.z = pk_bf16(y[4], y[5]); o.w = pk_bf16(y[6], y[7]);
                *(u32x4*)(yp + (size_t)(i0 + k) * rs) = o;
            }
            prev = xs[RB]; cur = xs[RB + 1];
        }
    }
}

namespace scan {
constexpr int PQ = 136, PT = 72, PU = 68;
constexpr int POS = 72;
constexpr int PV = 80;
constexpr int O_Q = 0, O_K = 34816, O_V = 69632, O_WT = 79872, O_UT = 98304, O_QK = 107008, O_NLF = 125440, O_DTF = 128512, O_TAB = 134656, O_TT = 137216, O_OS = 153856, LDS_END = 163072;
constexpr int IMG = 17408, QKB = 9216, TABB = 1280;
typedef float f32x16 __attribute__((ext_vector_type(16)));
__device__ __forceinline__ f32x4 mfma32(const bf16x8 a, const bf16x8 b, const f32x4 c) { return __builtin_amdgcn_mfma_f32_16x16x32_bf16(a, b, c, 0, 0, 0); }
__device__ __forceinline__ f32x4 mfma16(const bf16x4 a, const bf16x4 b, const f32x4 c) { return __builtin_amdgcn_mfma_f32_16x16x16bf16_1k(a, b, c, 0, 0, 0); }
__device__ __forceinline__ f32x16 mfmaL(const bf16x8 a, const bf16x8 b, const f32x16 c) { return __builtin_amdgcn_mfma_f32_32x32x16_bf16(a, b, c, 0, 0, 0); }
__device__ __forceinline__ bf16x4 ld8(const LAS bf16_t* p) { return *(const volatile LAS bf16x4*)p; }
__device__ __forceinline__ bf16x4 trd(const LAS bf16_t* p) { return __builtin_amdgcn_ds_read_tr16_b64_v4i16((LAS bf16x4*)p); }
__device__ __forceinline__ bf16x8 packL(const f32x16 x, const int s2) {
    return s2 == 0 ? pack8(__builtin_shufflevector(x, x, 0, 1, 2, 3), __builtin_shufflevector(x, x, 4, 5, 6, 7)) : pack8(__builtin_shufflevector(x, x, 8, 9, 10, 11), __builtin_shufflevector(x, x, 12, 13, 14, 15));
}
}

template <int CH0, int CH1> __device__ __forceinline__ void scan_b3(const Frame& F, const int rt, LAS bf16_t* Vs, LAS bf16_t* Kp, LAS bf16_t* UT, LAS bf16_t* WTp, LAS bf16x4* NLF, LAS bf16x4* DTF) {
    using namespace scan;
#define SCHED() __builtin_amdgcn_sched_barrier(0)
                    int l2 = F.lane; asm volatile("" : "+v"(l2));
                    const int n16 = l2 & 15, g4 = l2 >> 4; const int lane = l2;
                    const int trl = (4 * g4 + (n16 >> 2)) * PQ + 4 * (n16 & 3), trv = (4 * g4 + (n16 >> 2)) * PV + 4 * (n16 & 3);
                    bf16x4 nl[6], dt[4], du[4], dw[4];
#pragma unroll
                    for (int bb = 0; bb < 4; ++bb) { dt[bb] = DTF[bb * 64 + lane]; du[bb] = DTF[(4 + bb) * 64 + lane]; dw[bb] = DTF[(8 + bb) * 64 + lane]; }
#pragma unroll
                    for (int k = 0; k < 6; ++k) nl[k] = NLF[k * 64 + lane];
                    bf16x4 rr[4][4];
#pragma unroll
                    for (int ch = CH0; ch < CH1; ++ch)
#pragma unroll
                        for (int bb = 0; bb < 4; ++bb) rr[ch][bb] = trd((ch < 2 ? Vs + trv + 16 * bb * PV : Kp + trl + 16 * bb * PQ) + 32 * rt + 16 * (ch & 1));
                    SCHED();
                    bf16x4 xb[4][4];
                    const f32x4 z4 = (f32x4){0.f, 0.f, 0.f, 0.f};
#pragma unroll
                    for (int bb = 0; bb < 4; ++bb) {
#pragma unroll
                        for (int ch = CH0; ch < CH1; ++ch) {
                            f32x4 x = mfma16(ch < 2 ? du[bb] : dw[bb], rr[ch][bb], z4);
                            if (bb > 0) {
                                f32x4 y = z4;
#pragma unroll
                                for (int kb = 0; kb < 4; ++kb) if (kb < bb) y = mfma16(nl[bb * (bb - 1) / 2 + kb], xb[ch][kb], y);
                                x = mfma16(dt[bb], pack4(y), x);
                            }
                            xb[ch][bb] = pack4(x);
                            LAS bf16_t* dstp = (ch < 2 ? UT + (32 * rt + 16 * (ch & 1) + n16) * PU : WTp + (32 * rt + 16 * (ch & 1) + n16) * PT) + 16 * bb + 4 * g4;
                            *(LAS bf16x4*)dstp = xb[ch][bb];
                        }
                    }

#undef SCHED
}

template <bool DOK, bool DOQ> __device__ __forceinline__ void scan_b1(const Frame& F, const int rt, LAS bf16_t* Kp, LAS bf16_t* Qp, LAS float* Tp, LAS bf16_t* QKs, LAS bf16x4* NLF, LAS bf16x4* DTF) {
    using namespace scan;
#define SCHED() __builtin_amdgcn_sched_barrier(0)
                    int l1 = F.lane; asm volatile("" : "+v"(l1));
                    const int n16 = l1 & 15, g4 = l1 >> 4; const int lane = l1;
                    const LAS bf16_t* kb_ = Kp + n16 * PQ + 8 * g4;
                    const LAS bf16_t* okp = Kp + (16 * rt + n16) * PQ + 8 * g4; const LAS bf16_t* oqp = Qp + (16 * rt + n16) * PQ + 8 * g4;
                    bf16x8 ofk[4], ofq[4];
#pragma unroll
                    for (int s2 = 0; s2 < 4; ++s2) { if (DOK) ofk[s2] = *(const LAS bf16x8*)(okp + 32 * s2); if (DOQ) ofq[s2] = *(const LAS bf16x8*)(oqp + 32 * s2); }
                    f32x4 tg[4];
#pragma unroll
                    for (int t = 0; t < 4; ++t) tg[t] = *(const LAS f32x4*)(Tp + 16 * t + 4 * g4);
                    const f32x4 tbo = *(const LAS f32x4*)(Tp + 64 + 16 * rt + 4 * g4);
                    const float gci = Tp[16 * rt + n16], bei = Tp[64 + 16 * rt + n16];
                    f32x4 aK[4], aQ[4];
#pragma unroll
                    for (int t = 0; t < 4; ++t) { aK[t] = (f32x4){0.f, 0.f, 0.f, 0.f}; aQ[t] = (f32x4){0.f, 0.f, 0.f, 0.f}; }
#pragma unroll
                    for (int th = 0; th < 2; ++th) if (2 * th <= rt) {
                        bf16x8 kf[2][4];
#pragma unroll
                        for (int tt = 0; tt < 2; ++tt)
#pragma unroll
                            for (int s2 = 0; s2 < 4; ++s2) kf[tt][s2] = *(const LAS bf16x8*)(kb_ + 16 * (2 * th + tt) * PQ + 32 * s2);
                        SCHED();
#pragma unroll
                        for (int s2 = 0; s2 < 4; ++s2)
#pragma unroll
                            for (int tt = 0; tt < 2; ++tt) { if (DOK) aK[2 * th + tt] = mfma32(kf[tt][s2], ofk[s2], aK[2 * th + tt]); if (DOQ) aQ[2 * th + tt] = mfma32(kf[tt][s2], ofq[s2], aQ[2 * th + tt]); }
                        SCHED();
                    }
                    LAS bf16_t* qkw = QKs + (16 * rt + n16) * PU + 4 * g4;
#pragma unroll
                    for (int t = 0; t < 4; ++t) {
                        if (t <= rt) {
                            f32x4 dec;
#pragma unroll
                            for (int r = 0; r < 4; ++r) dec[r] = __expf(gci - tg[t][r]);
                            if (DOQ) { f32x4 o;
#pragma unroll
                                for (int r = 0; r < 4; ++r) { const bool ge = (t < rt) || (n16 >= 4 * g4 + r); o[r] = ge ? aQ[t][r] * dec[r] : 0.f; }
                                *(LAS bf16x4*)(qkw + 16 * t) = pack4(o); }
                            if (DOK && t < rt) {
                                f32x4 nl;
#pragma unroll
                                for (int r = 0; r < 4; ++r) nl[r] = -bei * aK[t][r] * dec[r];
                                NLF[(rt * (rt - 1) / 2 + t) * 64 + lane] = pack4(nl);
                            }
                        } else if (DOQ && t == rt + 1 && !(rt & 1)) {
                            *(LAS bf16x4*)(qkw + 16 * t) = (bf16x4){0, 0, 0, 0};
                        }
                    }
                    if (DOK) {
                        const f32x4 g = rt == 0 ? aK[0] : (rt == 1 ? aK[1] : (rt == 2 ? aK[2] : aK[3]));
                        const f32x4 tgo = rt == 0 ? tg[0] : (rt == 1 ? tg[1] : (rt == 2 ? tg[2] : tg[3]));
                        f32x4 Lc, LTc, T1T;
#pragma unroll
                        for (int r = 0; r < 4; ++r) {
                            const int aa = 4 * g4 + r;
                            Lc[r] = (aa > n16) ? tbo[r] * g[r] * __expf(tgo[r] - gci) : 0.f;
                            LTc[r] = (n16 > aa) ? bei * g[r] * __expf(gci - tgo[r]) : 0.f;
                            T1T[r] = ((aa == n16) ? 1.f : 0.f) - LTc[r];
                        }
                        const f32x4 z4 = (f32x4){0.f, 0.f, 0.f, 0.f};
                        const bf16x4 l = pack4(Lc), lt = pack4(LTc);
                        const f32x4 L2 = mfma16(lt, l, z4), L2T = mfma16(l, lt, z4);
                        const bf16x4 l2 = pack4(L2), l2t = pack4(L2T);
                        const f32x4 L4 = mfma16(l2t, l2, z4), L4T = mfma16(l2, l2t, z4);
                        const f32x4 T2T = mfma16(l2, pack4(T1T), T1T);
                        const bf16x4 l4 = pack4(L4), l4t = pack4(L4T);
                        const f32x4 L8 = mfma16(l4t, l4, z4);
                        const f32x4 T3T = mfma16(l4, pack4(T2T), T2T);
                        const f32x4 T4T = mfma16(pack4(L8), pack4(T3T), T3T);
                        DTF[rt * 64 + lane] = pack4(T4T);
                        const f32x4 teo = *(const LAS f32x4*)(Tp + 128 + 16 * rt + 4 * g4);
                        DTF[(4 + rt) * 64 + lane] = pack4(T4T * tbo);
                        DTF[(8 + rt) * 64 + lane] = pack4(T4T * tbo * teo);
                    }

#undef SCHED
}

__device__ __forceinline__ void p_scan(const Args& args, const Frame& F) {
    using namespace scan;
#define SCAN_BAR() do { asm volatile("s_waitcnt lgkmcnt(0)" ::: "memory"); __builtin_amdgcn_s_barrier(); asm volatile("" ::: "memory"); } while (0)
#define SCHED() __builtin_amdgcn_sched_barrier(0)
    const bf16_t* QKV = (const bf16_t*)(F.ws + WS_QKVP); const float* GB = (const float*)(F.ws + WS_GB);
    bf16_t* OFp = (bf16_t*)F.out; bf16_t* OBp = OFp + (size_t)T * D;
    LAS bf16_t* Vs = (LAS bf16_t*)(F.lds + O_V); LAS bf16_t* UT = (LAS bf16_t*)(F.lds + O_UT); LAS bf16_t* WT = (LAS bf16_t*)(F.lds + O_WT);
    LAS bf16x4* NLF = (LAS bf16x4*)(F.lds + O_NLF); LAS bf16x4* DTF = (LAS bf16x4*)(F.lds + O_DTF);
    const int tid = F.tid, wave = F.wave;
    const bool cons = wave < 2, helper = wave >= 2 && wave < 4;
    const int item = F.bid;
    if (item < NB * NH * 4) {
        const int vh = item & 1, dir = (item >> 1) & 1, h = (item >> 2) & 7, b = item >> 5;
        int tidv = F.tid; asm volatile("" : "+v"(tidv));
        const int tq0 = F.bid; const bool args_notr = args.li == 1;
        if (helper) {
            const int ht = tidv - 128;
            LAS float* TT = (LAS float*)(F.lds + O_TT);
            f32x4 tp[8]; TTile tc; bool tvalid = false;
            const int tr0 = ht >> 4, tc4 = (ht & 15) * 4;
            { const int q0 = tq0; if (!args_notr && q0 < TT_TILES) { tc = tt_decode(args, F, q0); tvalid = true;
#pragma unroll
                for (int p = 0; p < 8; ++p) tp[p] = *(const f32x4*)(tc.src + (size_t)(tr0 + 8 * p) * tc.ld + tc4); } }
            if (tvalid) {
#pragma unroll
                for (int p = 0; p < 8; ++p)
#pragma unroll
                    for (int j = 0; j < 4; ++j) TT[(tr0 + 8 * p) * 65 + tc4 + j] = tp[p][j];
            }
            SCAN_BAR();
            for (int s = 0; s <= 132; ++s) {
                const int pb = s & 1;
                LAS bf16_t* Kp = (LAS bf16_t*)(F.lds + O_K + pb * IMG); LAS bf16_t* QKp = (LAS bf16_t*)(F.lds + O_QK + pb * QKB);
                LAS bf16_t* Qp = (LAS bf16_t*)(F.lds + O_Q + pb * IMG); LAS float* Tp = (LAS float*)(F.lds + O_TAB + pb * TABB);
                const TTile tw = tc; const bool wvalid = tvalid;
                if (wvalid) {
                    const int n = ht >> 1, kk = (ht & 1) * 32;
                    float o[32];
#pragma unroll
                    for (int j = 0; j < 32; ++j) o[j] = TT[(kk + j) * 65 + n] * tw.sc;
                    if (tw.fp8) {
#pragma unroll
                        for (int g = 0; g < 2; ++g) { u32x4 w; w.x = pk_fp8x4(o[16 * g], o[16 * g + 1], o[16 * g + 2], o[16 * g + 3]); w.y = pk_fp8x4(o[16 * g + 4], o[16 * g + 5], o[16 * g + 6], o[16 * g + 7]);
                            w.z = pk_fp8x4(o[16 * g + 8], o[16 * g + 9], o[16 * g + 10], o[16 * g + 11]); w.w = pk_fp8x4(o[16 * g + 12], o[16 * g + 13], o[16 * g + 14], o[16 * g + 15]);
                            *(u32x4*)(tw.dst + (size_t)n * tw.ldd + kk + 16 * g) = w; }
                    } else {
#pragma unroll
                        for (int g = 0; g < 4; ++g) { u32x4 w; w.x = pk_bf16(o[8 * g], o[8 * g + 1]); w.y = pk_bf16(o[8 * g + 2], o[8 * g + 3]); w.z = pk_bf16(o[8 * g + 4], o[8 * g + 5]); w.w = pk_bf16(o[8 * g + 6], o[8 * g + 7]);
                            *(u32x4*)(tw.dst + (size_t)n * tw.ldd + (kk + 8 * g) * 2) = w; }
                    }
                }
                { const int qn = tq0 + (s + 1) * F.G; tvalid = !args_notr && s < 132 && qn < TT_TILES;
                  if (tvalid) { tc = tt_decode(args, F, qn);
#pragma unroll
                    for (int p = 0; p < 8; ++p) tp[p] = *(const f32x4*)(tc.src + (size_t)(tr0 + 8 * p) * tc.ld + tc4); } }
                if (s < 132) scan_b1<false, true>(F, wave, Kp, Qp, Tp, QKp, NLF, DTF);
                SCAN_BAR();
                if (s < 132) scan_b3<0, 2>(F, wave - 2, Vs, Kp, UT, WT, NLF, DTF);
                if (tvalid) {
#pragma unroll
                    for (int p = 0; p < 8; ++p)
#pragma unroll
                        for (int j = 0; j < 4; ++j) TT[(tr0 + 8 * p) * 65 + tc4 + j] = tp[p][j];
                }
                SCAN_BAR();
            }
        } else if (cons) {
            f32x16 St[4];
#pragma unroll
            for (int d = 0; d < 4; ++d)
#pragma unroll
                for (int i = 0; i < 16; ++i) St[d][i] = 0.f;
            __builtin_amdgcn_s_setprio(2);
            SCAN_BAR(); SCAN_BAR();
            bf16x8 Sb[4][2];
#pragma unroll
            for (int d = 0; d < 4; ++d) { Sb[d][0] = packL(St[d], 0); Sb[d][1] = packL(St[d], 1); }
            for (int s = 1; s <= 132; ++s) {
                const int cb = (s + 1) & 1;
                LAS bf16_t* Qc = (LAS bf16_t*)(F.lds + O_Q + cb * IMG); LAS bf16_t* Kc = (LAS bf16_t*)(F.lds + O_K + cb * IMG);
                LAS bf16_t* QKc = (LAS bf16_t*)(F.lds + O_QK + cb * QKB);
                LAS float* Tc = (LAS float*)(F.lds + O_TAB + cb * TABB);
                const int cc = s - 1;
                const bool isctx = cc < 4; const int c = isctx ? cc : cc - 4; const int L = isctx ? CTXL : SEQ;
                const int t0 = dir ? (L - 1 - 64 * c) : 64 * c; const int ts = dir ? -1 : 1;
                bf16x8 Vd[2][2], qa[8]; f32x16 Oq[2], A1;
                SCAN_BAR();
                {
                int l1 = F.lane; asm volatile("" : "+v"(l1));
                const int n32 = l1 & 31, hh = l1 >> 5, n16 = l1 & 15, grp = (l1 >> 4) & 1;
                const int e = 32 * wave + n32;
                const LAS bf16_t* utr = UT + e * PU + 4 * hh;
                const LAS bf16_t* wtr = WT + (4 * hh + (n16 >> 2)) * PT + 16 * grp + 4 * (n16 & 3);
                const LAS bf16_t* qkr = QKc + n32 * PU + 4 * hh;
                const LAS float* kdp = Tc + 192 + 4 * hh;
                bf16x8 wfa[8], wfb[8]; bf16x4 ur[2][4];
#pragma unroll
                for (int k = 0; k < 8; ++k) wfa[k] = cat8(trd(wtr + (16 * k) * PT), trd(wtr + (16 * k + 8) * PT));
#pragma unroll
                for (int mt = 0; mt < 2; ++mt)
#pragma unroll
                    for (int q = 0; q < 4; ++q) ur[mt][q] = ld8(utr + 32 * mt + 8 * q);
                SCHED();
                f32x16 zero16;
#pragma unroll
                for (int i = 0; i < 16; ++i) zero16[i] = 0.f;
                f32x16 P0 = zero16, P1 = zero16, vn0, vn1;
#pragma unroll
                for (int k = 0; k < 8; ++k) {
                    P0 = mfmaL(wfa[k], Sb[k >> 1][k & 1], P0);
                    wfb[k] = cat8(trd(wtr + (16 * k) * PT + 32), trd(wtr + (16 * k + 8) * PT + 32));
                    { const bf16x4 uv = ur[k >> 2][k & 3];
#pragma unroll
                      for (int r = 0; r < 4; ++r) { if (k < 4) vn0[4 * (k & 3) + r] = bf2f((bf16_t)uv[r]); else vn1[4 * (k & 3) + r] = bf2f((bf16_t)uv[r]); } }
                    SCHED();
                }
                bf16x8 Vb[2][2], a00[2], a10[2], a11[2]; f32x4 kd0[4], kd1[4];
#pragma unroll
                for (int k = 0; k < 8; ++k) {
                    P1 = mfmaL(wfb[k], Sb[k >> 1][k & 1], P1);
                    if (k == 0) {
#pragma unroll
                        for (int q = 0; q < 4; ++q) kd0[q] = *(const LAS f32x4*)(kdp + 8 * q);
                    }
                    if (k == 1) {
#pragma unroll
                        for (int s2 = 0; s2 < 2; ++s2) a00[s2] = cat8(ld8(qkr + 16 * s2), ld8(qkr + 16 * s2 + 8));
                    }
                    if (k >= 2 && k < 6) {
#pragma unroll
                        for (int r = 0; r < 4; ++r) vn0[4 * (k - 2) + r] = vn0[4 * (k - 2) + r] - P0[4 * (k - 2) + r];
                    }
                    if (k == 5) {
#pragma unroll
                        for (int s2 = 0; s2 < 2; ++s2) a10[s2] = cat8(ld8(qkr + 32 * PU + 16 * s2), ld8(qkr + 32 * PU + 16 * s2 + 8));
                    }
                    if (k == 6) { Vb[0][0] = packL(vn0, 0); Vb[0][1] = packL(vn0, 1); }
                    if (k == 7) {
#pragma unroll
                        for (int q = 0; q < 4; ++q)
#pragma unroll
                            for (int r = 0; r < 4; ++r) vn0[4 * q + r] = vn0[4 * q + r] * kd0[q][r];
                    }
                    SCHED();
                }
                Oq[0] = mfmaL(a00[0], Vb[0][0], zero16);
                Vd[0][0] = packL(vn0, 0); Vd[0][1] = packL(vn0, 1);
#pragma unroll
                for (int q = 0; q < 4; ++q) kd1[q] = *(const LAS f32x4*)(kdp + 32 + 8 * q);
#pragma unroll
                for (int s2 = 0; s2 < 2; ++s2) a11[s2] = cat8(ld8(qkr + 32 * PU + 32 + 16 * s2), ld8(qkr + 32 * PU + 32 + 16 * s2 + 8));
                SCHED();
                Oq[0] = mfmaL(a00[1], Vb[0][1], Oq[0]);
#pragma unroll
                for (int i = 0; i < 8; ++i) vn1[i] = vn1[i] - P1[i];
                SCHED();
                Oq[1] = mfmaL(a10[0], Vb[0][0], zero16);
#pragma unroll
                for (int i = 8; i < 16; ++i) vn1[i] = vn1[i] - P1[i];
                SCHED();
                Oq[1] = mfmaL(a10[1], Vb[0][1], Oq[1]);
                Vb[1][0] = packL(vn1, 0); Vb[1][1] = packL(vn1, 1);
                SCHED();
                Oq[1] = mfmaL(a11[0], Vb[1][0], Oq[1]);
#pragma unroll
                for (int q = 0; q < 4; ++q)
#pragma unroll
                    for (int r = 0; r < 4; ++r) vn1[4 * q + r] = vn1[4 * q + r] * kd1[q][r];
                SCHED();
                Oq[1] = mfmaL(a11[1], Vb[1][1], Oq[1]);
                Vd[1][0] = packL(vn1, 0); Vd[1][1] = packL(vn1, 1);

                    const LAS bf16_t* qsr0 = Qc + n32 * PQ + 4 * hh;
#pragma unroll
                    for (int k = 0; k < 8; ++k) qa[k] = cat8(ld8(qsr0 + 16 * k), ld8(qsr0 + 16 * k + 8));
                }
                SCHED();
                {
                    int l2 = F.lane; asm volatile("" : "+v"(l2));
                    const int n32 = l2 & 31, hh = l2 >> 5;
                    const LAS bf16_t* qsr = Qc + n32 * PQ + 4 * hh + 32 * PQ;
                    const LAS float* egp = Tc + 128 + 4 * hh;
                    bf16x8 qb[8]; f32x4 eg0[4];
                    f32x16 zero16;
#pragma unroll
                    for (int i = 0; i < 16; ++i) zero16[i] = 0.f;
                    f32x16 A0 = zero16; A1 = zero16;
#pragma unroll
                    for (int k = 0; k < 8; ++k) {
                        A0 = mfmaL(qa[k], Sb[k >> 1][k & 1], A0);
                        qb[k] = cat8(ld8(qsr + 16 * k), ld8(qsr + 16 * k + 8));
                        if (k == 0) {
#pragma unroll
                            for (int q = 0; q < 4; ++q) eg0[q] = *(const LAS f32x4*)(egp + 8 * q);
                        }
                        SCHED();
                    }
#pragma unroll
                    for (int k = 0; k < 8; ++k) {
                        A1 = mfmaL(qb[k], Sb[k >> 1][k & 1], A1);
                        if (k >= 2 && k < 6) {
#pragma unroll
                            for (int r = 0; r < 4; ++r) Oq[0][4 * (k - 2) + r] = A0[4 * (k - 2) + r] * eg0[k - 2][r] + Oq[0][4 * (k - 2) + r];
                        }
                        SCHED();
                    }
                }
                SCHED();
                {
                    int l3 = F.lane; asm volatile("" : "+v"(l3));
                    const int n32 = l3 & 31, hh = l3 >> 5, n16 = l3 & 15, grp = (l3 >> 4) & 1;
                    const int e = 32 * wave + n32;
                    const LAS bf16_t* ktr = Kc + (4 * hh + (n16 >> 2)) * PQ + 16 * grp + 4 * (n16 & 3);
                    const LAS float* egp = Tc + 128 + 32 + 4 * hh;
                    bf16x8 ka[8], kb2[8]; f32x4 eg1[4];
#pragma unroll
                    for (int j = 0; j < 8; ++j) ka[j] = cat8(trd(ktr + (16 * (j & 3)) * PQ + 32 * (j >> 2)), trd(ktr + (16 * (j & 3) + 8) * PQ + 32 * (j >> 2)));
#pragma unroll
                    for (int q = 0; q < 4; ++q) eg1[q] = *(const LAS f32x4*)(egp + 8 * q);
                    const float egl = Tc[256];
                    SCHED();
#pragma unroll
                    for (int q = 0; q < 4; ++q)
#pragma unroll
                        for (int r = 0; r < 4; ++r) Oq[1][4 * q + r] = A1[4 * q + r] * eg1[q][r] + Oq[1][4 * q + r];
                    St[0] = St[0] * egl; St[1] = St[1] * egl;
                    SCHED();
#pragma unroll
                    for (int j = 0; j < 8; ++j) {
                        if (j < 4) St[0] = mfmaL(ka[j], Vd[(j & 3) >> 1][j & 1], St[0]); else St[1] = mfmaL(ka[j], Vd[(j & 3) >> 1][j & 1], St[1]);
                        kb2[j] = cat8(trd(ktr + (16 * (j & 3)) * PQ + 32 * (2 + (j >> 2))), trd(ktr + (16 * (j & 3) + 8) * PQ + 32 * (2 + (j >> 2))));
#pragma unroll
                        for (int r = 0; r < 4; ++r) { if (j < 4) St[2][4 * (j & 3) + r] = St[2][4 * (j & 3) + r] * egl; else St[3][4 * (j & 3) + r] = St[3][4 * (j & 3) + r] * egl; }
                        SCHED();
                    }
#pragma unroll
                    for (int j = 0; j < 8; ++j) {
                        if (j < 4) St[2] = mfmaL(kb2[j], Vd[(j & 3) >> 1][j & 1], St[2]); else St[3] = mfmaL(kb2[j], Vd[(j & 3) >> 1][j & 1], St[3]);
                        SCHED();
                    }
                }
                SCAN_BAR();
                {
                    int l4 = F.lane; asm volatile("" : "+v"(l4));
                    const int n32 = l4 & 31, hh = l4 >> 5;
                    LAS bf16_t* Os = (LAS bf16_t*)(F.lds + O_OS);
                    if (!isctx) {
                        LAS bf16_t* osw = Os + (4 * hh) * POS + 32 * wave + n32;
#pragma unroll
                        for (int mt = 0; mt < 2; ++mt)
#pragma unroll
                            for (int q = 0; q < 4; ++q)
#pragma unroll
                                for (int r = 0; r < 4; ++r) osw[(32 * mt + 8 * q + r) * POS] = f2bf(Oq[mt][4 * q + r]);
                    }
#pragma unroll
                    for (int d = 0; d < 4; ++d) { Sb[d][0] = packL(St[d], 0); Sb[d][1] = packL(St[d], 1); }
                    if (!isctx) {
                        asm volatile("s_waitcnt lgkmcnt(0)" ::: "memory");
                        bf16_t* ob = dir ? OBp : OFp;
#pragma unroll
                        for (int q = 0; q < 4; ++q) { const int id = l4 + 64 * q; const int i = id >> 2, c4 = id & 3; const int t = t0 + ts * i;
                            const u32x4 v = *(const LAS u32x4*)(Os + i * POS + 32 * wave + 8 * c4);
                            *(u32x4*)(ob + (size_t)(b * SEQ + t) * D + h * HD + 64 * vh + 32 * wave + 8 * c4) = v; }
                    }
                }
            }
            SCAN_BAR();
            __builtin_amdgcn_s_setprio(0);
        } else {
            const int ptid = tidv - 256;
            u32x4 pf[10]; float pfa = 0.f, pfb = 0.f;
            const unsigned voff = (unsigned)((dir ? (15 - (ptid >> 4)) : (ptid >> 4)) * (3 * D * 2) + (ptid & 15) * 16);
            const int lst = (ptid >> 4) * PQ + 8 * (ptid & 15);
#define SCAN_PREFETCH(cc_, q0_, q1_, gates_) do { const int cc__ = (cc_); const bool ic_ = cc__ < 4; const int c_ = ic_ ? cc__ : cc__ - 4; const int L_ = ic_ ? CTXL : SEQ; const int rb_ = ic_ ? (T + b * CTXL) : b * SEQ; \
            const int t0_ = dir ? (L_ - 1 - 64 * c_) : 64 * c_; const int ts_ = dir ? -1 : 1; \
            const char* ub_ = (const char*)QKV + ((long)(rb_ + t0_) * (3 * D * 2) + h * (HD * 2) - (dir ? 15 * (3 * D * 2) : 0)); \
            _Pragma("unroll") for (int q_ = q0_; q_ < q1_; ++q_) { if (q_ < 8) pf[q_] = *(const u32x4*)(ub_ + ((long)(q_ >> 2) * (D * 2) + (long)ts_ * 16 * (q_ & 3) * (3 * D * 2)) + voff); \
                else pf[q_] = *(const u32x4*)((const char*)QKV + ((long)(rb_ + t0_ + ts_ * ((ptid >> 3) + 32 * (q_ - 8))) * (3 * D * 2) + 2 * (D * 2) + h * (HD * 2) + vh * 128 + (ptid & 7) * 16)); } \
            if (gates_ && wave == 4) { const size_t row_ = (size_t)(rb_ + t0_ + ts_ * F.lane); pfa = GB[row_ * 32 + 16 + dir * 8 + h]; pfb = GB[row_ * 32 + dir * 8 + h]; } } while (0)
            const int rt = wave - 4;
#define SCAN_STAGE_QK(cc_) do { const int bq_ = (cc_) & 1; LAS bf16_t* Qn_ = (LAS bf16_t*)(F.lds + O_Q + bq_ * IMG); LAS bf16_t* Kn_ = (LAS bf16_t*)(F.lds + O_K + bq_ * IMG); LAS float* Tn_ = (LAS float*)(F.lds + O_TAB + bq_ * TABB); \
            int lane_ = F.lane; asm volatile("" : "+v"(lane_)); \
            if (wave == 4) { const float gc_ = pfa; const float gl_ = __uint_as_float(__builtin_amdgcn_readlane(__float_as_uint(gc_), 63)); \
                Tn_[lane_] = gc_; Tn_[64 + lane_] = pfb; Tn_[128 + lane_] = __expf(gc_); Tn_[192 + lane_] = __expf(gl_ - gc_); if (lane_ == 0) Tn_[256] = __expf(gl_); } \
            _Pragma("unroll") for (int q_ = 0; q_ < 8; ++q_) { LAS bf16_t* dst_ = ((q_ >> 2) == 0 ? Qn_ : Kn_) + lst + 16 * (q_ & 3) * PQ; *(LAS u32x4*)dst_ = pf[q_]; } } while (0)
            SCAN_PREFETCH(0, 0, 10, true);
            SCAN_STAGE_QK(0);
            SCAN_PREFETCH(1, 0, 8, true);
            SCAN_BAR();
            for (int s = 0; s <= 132; ++s) {
                const int pb = s & 1;
                LAS bf16_t* Qp = (LAS bf16_t*)(F.lds + O_Q + pb * IMG); LAS bf16_t* Kp = (LAS bf16_t*)(F.lds + O_K + pb * IMG);
                LAS bf16_t* QKp = (LAS bf16_t*)(F.lds + O_QK + pb * QKB); LAS float* Tp = (LAS float*)(F.lds + O_TAB + pb * TABB);
                const bool act = s < 132;
                if (act) {
                    if (rt < 2) scan_b1<true, true>(F, rt, Kp, Qp, Tp, QKp, NLF, DTF); else scan_b1<true, false>(F, rt, Kp, Qp, Tp, QKp, NLF, DTF);
#pragma unroll
                    for (int q = 8; q < 10; ++q) *(LAS u32x4*)(Vs + ((ptid >> 3) + 32 * (q - 8)) * PV + 8 * (ptid & 7)) = pf[q];
                    if (s + 1 < 132) SCAN_PREFETCH(s + 1, 8, 10, false);
                }
                SCAN_BAR();
                if (act) {
                    scan_b3<2, 4>(F, rt, Vs, Kp, UT, WT, NLF, DTF);
                    if (s + 1 < 132) { SCAN_STAGE_QK(s + 1); if (s + 2 < 132) SCAN_PREFETCH(s + 2, 0, 8, true); }
                }
                SCAN_BAR();
            }
#undef SCAN_STAGE_QK
#undef SCAN_PREFETCH
        }
        __syncthreads();
    }
#undef SCAN_BAR
#undef SCHED
}

constexpr int LDS_BYTES = 163840;
constexpr int LDS_XB = LDS_BYTES - 16;
static_assert(scan::LDS_END <= LDS_XB && pg8::STAGE_BYTES + 2048 + 256 <= LDS_XB && 38 * 1024 * 4 + 128 <= LDS_XB, "LDS map");

__device__ __forceinline__ void moe_gemms(const Frame& F, const int l, const bool do1, const bool do2, const XcdBarrier& bar, const bool barrier_between) {
    const int* ESTART = (const int*)(F.ws + WS_META) + 256 * 32;
    LAS int* est = (LAS int*)(F.lds + pg8::TOK_OFF + 2048);
    if (do1) {
        __syncthreads();
        if (F.tid < 33) est[F.tid] = ESTART[F.tid];
        __syncthreads();
        pg8::MoeOrder S{est, F.G, F.bid, 4};
        EpiSwiglu E{(unsigned char*)(F.ws + WS_H)};
        pg8::gemm_phase<EpiSwiglu, pg8::MoeOrder, true, 1>(F.lds, (const bf16_t*)(F.ws + WS_A1), (const bf16_t*)((const unsigned char*)(F.ws + WS_W13) + (size_t)l * NE * 1024 * 1024), D, S, E, (const int*)(F.ws + WS_ROWTOK));
    }
    if (barrier_between) xcd_barrier(bar);
    if (do2) {
        if (!do1) {
            __syncthreads();
            if (F.tid < 33) est[F.tid] = ESTART[F.tid];
            __syncthreads();
        }
        pg8::MoeOrder S{est, F.G, F.bid, 4};
        EpiStoreFp8 E{(unsigned char*)(F.ws + WS_YB), D, YB_SCALE / (H_SCALE * W2_SCALE)};
        pg8::gemm_phase<EpiStoreFp8, pg8::MoeOrder, false, 1>(F.lds, (const bf16_t*)(F.ws + WS_H), (const bf16_t*)((const unsigned char*)(F.ws + WS_W2) + (size_t)l * NE * 1024 * 512), DE, S, E, nullptr);
    }
}

__global__ void __launch_bounds__(NTHREADS, 2) hybrid_fwd(Args args) {
    extern __shared__ __attribute__((aligned(16))) unsigned char lds_raw[];
    Frame F;
    F.lds = (LAS unsigned char*)lds_raw; F.tid = threadIdx.x; F.lane = F.tid & 63; F.wave = __builtin_amdgcn_readfirstlane(F.tid >> 6); F.G = gridDim.x; F.bid = blockIdx.x;
    F.out = args.out; F.ws = args.ws;
    const int lo = args.ph_lo, hi = args.ph_hi;
    unsigned* barw = (unsigned*)(F.ws + WS_CTL) + args.li * XCD_BAR_WORDS;
    XcdBarrier bar; bar.bar = barw; bar.x = 0; bar.st = (volatile LAS unsigned*)(F.lds + LDS_XB);
    if (hi - lo > 1) {
        if (F.tid == 0) { bar.st[0] = 0u; bar.st[1] = 0u; }
        __syncthreads();
        bar = xcd_barrier_post(barw, (volatile LAS unsigned*)(F.lds + LDS_XB));
    }
#ifndef PH_MASK
#define PH_MASK 0xfffff
#endif
#define IN(k) ((((PH_MASK) >> (k)) & 1) && lo <= (k) && (k) < hi)
#define SEAM(k) do { if (IN(k) && IN((k) + 1)) xcd_barrier(bar); } while (0)
    if (IN(0)) p0_prologue(args, F);
    SEAM(0);
    if (IN(1)) p_modulate0(args, F);
    SEAM(1);
    if (IN(2)) {
        pg8::StaticOrder S; S.init(MROWS, NPROJ_PAD, F.G, F.bid);
        EpiInProj E{(bf16_t*)(F.ws + WS_QKVP), (bf16_t*)(F.ws + WS_Z), (float*)(F.ws + WS_GB), (bf16_t*)(F.ws + WS_HALO)};
        pg8::gemm_phase<EpiInProj, pg8::StaticOrder, false>(F.lds, (const bf16_t*)(F.ws + WS_A1), (const bf16_t*)(F.ws + WS_WINA), D, S, E, nullptr);
    }
    SEAM(2);
    if (IN(3)) p_qkvprep(args, F);
    SEAM(3);
    if (IN(4)) {
        p_scan(args, F); __syncthreads();
        if (args.li != 1) p_transposes(args, F, F.bid + F.G * 133, F.G);
    }
    SEAM(4);
    if (IN(5)) p_finish(args, F);
    SEAM(5);
    if (IN(6)) {
        pg8::StaticOrder S; S.init(T, D, F.G, F.bid);
        EpiResid<false> E{args.in[0], (bf16_t*)(F.ws + WS_X), (const float*)(F.ws + WS_MOD) + 2 * 1024};
        pg8::gemm_phase<EpiResid<false>, pg8::StaticOrder, false>(F.lds, (const bf16_t*)(F.ws + WS_A1), (const bf16_t*)(F.ws + WS_WOUTA), D, S, E, nullptr);
    }
    SEAM(6);
    if (IN(7)) p_ffn_route(args, F, 0);
    SEAM(7);
    if (IN(8)) p_slots(args, F);
    SEAM(8);
    if (IN(9) || IN(10)) moe_gemms(F, 0, IN(9), IN(10), bar, IN(9) && IN(10));
    SEAM(10);
    if (IN(11)) p_combine<false>(args, F, 0);
    SEAM(11);
    if (IN(12)) {
        pg8::StaticOrder S; S.init(T, 3 * D, F.G, F.bid);
        EpiInB E{(bf16_t*)(F.ws + WS_GATEB), (bf16_t*)(F.ws + WS_U)};
        pg8::gemm_phase<EpiInB, pg8::StaticOrder, false>(F.lds, (const bf16_t*)(F.ws + WS_A1), (const bf16_t*)(F.ws + WS_WINB), D, S, E, nullptr);
    }
    SEAM(12);
    if (IN(13)) p_convgrid(args, F);
    SEAM(13);
    if (IN(14)) {
        pg8::StaticOrder S; S.init(T, D, F.G, F.bid);
        EpiResid<true> E{(const void*)(F.ws + WS_X), (bf16_t*)(F.ws + WS_X), (const float*)(F.ws + WS_MOD) + (size_t)9 * 6144 + 2 * 1024};
        pg8::gemm_phase<EpiResid<true>, pg8::StaticOrder, false>(F.lds, (const bf16_t*)(F.ws + WS_YY), (const bf16_t*)(F.ws + WS_WOUTB), D, S, E, nullptr);
    }
    SEAM(14);
    if (IN(15)) p_ffn_route(args, F, 1);
    SEAM(15);
    if (IN(16)) p_slots(args, F);
    SEAM(16);
    if (IN(17) || IN(18)) moe_gemms(F, 1, IN(17), IN(18), bar, IN(17) && IN(18));
    SEAM(18);
    if (IN(19)) p_combine<true>(args, F, 1);
#undef IN
#undef SEAM
}

extern "C" void kernel_launch(void* const* d_in, const int* in_sizes, int n_in, void* d_out, int out_size, void* d_ws, size_t ws_size, hipStream_t stream) {
    static int grid = 0;
    if (grid == 0) {
        if (n_in != 23 || out_size != T * D || ws_size < WS_END) { fprintf(stderr, "kernel_launch: unexpected problem shape (n_in %d, out %d, ws %zu < %zu)\n", n_in, out_size, ws_size, (size_t)WS_END); grid = -1; return; }
        int dev = 0, cus = 0, per_cu = 0;
        if (hipGetDevice(&dev) != hipSuccess || hipDeviceGetAttribute(&cus, hipDeviceAttributeMultiprocessorCount, dev) != hipSuccess) { grid = -1; return; }
        if (hipFuncSetAttribute((const void*)hybrid_fwd, hipFuncAttributeMaxDynamicSharedMemorySize, LDS_BYTES) != hipSuccess) { fprintf(stderr, "kernel_launch: hipFuncSetAttribute failed\n"); grid = -1; return; }
        if (hipOccupancyMaxActiveBlocksPerMultiprocessor(&per_cu, (const void*)hybrid_fwd, NTHREADS, LDS_BYTES) != hipSuccess || per_cu < 1) { fprintf(stderr, "kernel_launch: occupancy query says %d\n", per_cu); }
        (void)hipGetLastError();
        if (cus < NB * NH * 4) { fprintf(stderr, "kernel_launch: %d CUs, the scan phase needs %d co-resident workgroups\n", cus, NB * NH * 4); grid = -1; return; }
        grid = cus;
    }
    if (grid < 0) return;
    (void)hipMemsetAsync((char*)d_ws + WS_CTL, 0, CTL_BYTES, stream);
    Args a{};
    for (int i = 0; i < 23; ++i) a.in[i] = (const float*)d_in[i];
    a.out = (float*)d_out; a.ws = (unsigned char*)d_ws;
#if defined(PROBE_LO)
    a.ph_lo = 0; a.ph_hi = PROBE_HI; a.li = 0; hipLaunchKernelGGL(hybrid_fwd, dim3(grid), dim3(NTHREADS), LDS_BYTES, stream, a);
    a.ph_lo = PROBE_LO; a.ph_hi = PROBE_HI; a.li = 1; hipLaunchKernelGGL(hybrid_fwd, dim3(grid), dim3(NTHREADS), LDS_BYTES, stream, a);
    a.ph_lo = PROBE_HI; a.ph_hi = N_PHASES; a.li = 2; hipLaunchKernelGGL(hybrid_fwd, dim3(grid), dim3(NTHREADS), LDS_BYTES, stream, a);
#elif MK_ONE_LAUNCH
    a.ph_lo = 0; a.ph_hi = N_PHASES;
    hipLaunchKernelGGL(hybrid_fwd, dim3(grid), dim3(NTHREADS), LDS_BYTES, stream, a);
#else
    for (int p = 0; p < N_PHASES; ++p) { a.ph_lo = p; a.ph_hi = p + 1; hipLaunchKernelGGL(hybrid_fwd, dim3(grid), dim3(NTHREADS), LDS_BYTES, stream, a); }
#endif
}
```
